# Optimizing an MI355X kernel written in HIP

```python
import jax, jax.numpy as jnp
from jax import lax
import numpy as np

D_MODEL = 1024
BATCH = 8
SEQ = 4096
DEPTH = 1

HEAD_DIM = 64
ROPE_THETA = 10000.0
Q_BLOCK = 128
A_HEADS = 8
A_WIDTH = A_HEADS * HEAD_DIM
A_KV_RANK = 128
A_IDX_HEADS = 4
A_IDX_DIM = 64
A_TOPK_MAX = 256
B_HEADS = 8
B_GROUPS = 2
B_REP = B_HEADS // B_GROUPS
B_WIDTH = B_HEADS * HEAD_DIM
B_KV_WIDTH = B_GROUPS * HEAD_DIM
B_CMP_STRIDE = 16
B_CMP_LEN = 2 * B_CMP_STRIDE
B_CMP_HIDDEN = 256
B_SLC_LEN = 64
B_SLC_TOP = 16
B_WINDOW = 512
D_FF = 2816
MIX_IN_WIDTH = (A_WIDTH + A_KV_RANK + A_IDX_HEADS * A_IDX_DIM + A_IDX_DIM + A_IDX_HEADS
                + B_WIDTH + 6 * B_KV_WIDTH + 3 * B_HEADS + 2 * D_MODEL)
N_MOD = 9
ALPHA = (2.0 * DEPTH) ** 0.25
BETA = (8.0 * DEPTH) ** -0.25
LN_EPS = 1e-5
NEG = -1e30
FORCE_BONUS = 1e4

kernel_name = "hybrid_dsa_nsa_macaron_deepnorm_adaln"


def layer_norm(x, g, b):
    xf = x.astype(jnp.float32)
    mu = jnp.mean(xf, -1, keepdims=True)
    var = jnp.mean(jnp.square(xf - mu), -1, keepdims=True)
    return ((xf - mu) * lax.rsqrt(var + LN_EPS) * g + b).astype(x.dtype)


def rms_norm(x, g):
    xf = x.astype(jnp.float32)
    return (xf * lax.rsqrt(jnp.mean(jnp.square(xf), -1, keepdims=True) + LN_EPS) * g).astype(x.dtype)


def rope(x, pos):
    half = x.shape[-1] // 2
    inv = ROPE_THETA ** (-jnp.arange(half, dtype=jnp.float32) / half)
    ang = pos.astype(jnp.float32)[:, None] * inv[None, :]
    cos = jnp.cos(ang)[:, None, :]
    sin = jnp.sin(ang)[:, None, :]
    xf = x.astype(jnp.float32)
    x1, x2 = xf[..., :half], xf[..., half:]
    return jnp.concatenate([x1 * cos - x2 * sin, x1 * sin + x2 * cos], -1).astype(x.dtype)


def masked_softmax(s, mask):
    s = jnp.where(mask, s.astype(jnp.float32), NEG)
    return jax.nn.softmax(s, axis=-1) * mask


def swiglu(u, w_in, w_out):
    a, b = jnp.split(u @ w_in, 2, axis=-1)
    return (jax.nn.silu(a) * b) @ w_out


def modulate(x, shift, scale):
    return x * (1.0 + scale[:, None, :]) + shift[:, None, :]


def gather_rows(table, idx):
    return jax.vmap(lambda t, i: t[i])(table, idx)


def dsa_mixer(q, kv_lat, qi, ki, wi, kv_norm_g, w_kv_up, pos):
    B, S, _ = q.shape
    q = rope(q.reshape(B, S, A_HEADS, HEAD_DIM), pos)
    k, v = jnp.split(rms_norm(kv_lat, kv_norm_g) @ w_kv_up, 2, axis=-1)
    k = rope(k[:, :, None, :], pos)[:, :, 0]
    qi = rope(qi.reshape(B, S, A_IDX_HEADS, A_IDX_DIM), pos)
    ki = rope(ki[:, :, None, :], pos)[:, :, 0]
    wi = (wi * (A_IDX_HEADS ** -0.5)).astype(jnp.float32)
    topk = min(A_TOPK_MAX, S // 4)
    kpos = jnp.arange(S)

    def block(n):
        q0 = n * Q_BLOCK
        tq = q0 + jnp.arange(Q_BLOCK)
        qb = lax.dynamic_slice_in_dim(q, q0, Q_BLOCK, 1)
        qib = lax.dynamic_slice_in_dim(qi, q0, Q_BLOCK, 1)
        wib = lax.dynamic_slice_in_dim(wi, q0, Q_BLOCK, 1)
        logits = jnp.einsum('bqhd,bsd->bqhs', qib, ki).astype(jnp.float32)
        score = jnp.einsum('bqh,bqhs->bqs', wib, jax.nn.relu(logits))
        score = jnp.where(kpos[None, None, :] <= tq[None, :, None], score, NEG)
        _, sel = lax.top_k(score, topk)
        valid = sel <= tq[None, :, None]
        k_sel = gather_rows(k, sel)
        v_sel = gather_rows(v, sel)
        s = jnp.einsum('bqhd,bqkd->bhqk', qb, k_sel).astype(jnp.float32) * (HEAD_DIM ** -0.5)
        p = masked_softmax(s, valid[:, None])
        return jnp.einsum('bhqk,bqkd->bqhd', p.astype(v.dtype), v_sel)

    o = lax.map(block, jnp.arange(S // Q_BLOCK))
    return jnp.moveaxis(o, 0, 1).reshape(B, S, A_WIDTH)


def compress(t, pe, w1, w2):
    B, S, G, D = t.shape
    chunks = t.reshape(B, S // B_CMP_STRIDE, B_CMP_STRIDE, G, D)
    blocks = jnp.concatenate([chunks[:, :-1], chunks[:, 1:]], axis=2) + pe[:, None, :]
    flat = jnp.transpose(blocks, (0, 1, 3, 2, 4)).reshape(B, -1, G, B_CMP_LEN * D)
    return jax.nn.silu(flat @ w1) @ w2


def nsa_mixer(q, kv6, gates, pe_k, w1_k, w2_k, pe_v, w1_v, w2_v, pos):
    B, S, _ = q.shape
    q = rope(q.reshape(B, S, B_HEADS, HEAD_DIM), pos).reshape(B, S, B_GROUPS, B_REP, HEAD_DIM)
    kc, vc, ks, vs, kw, vw = [t.reshape(B, S, B_GROUPS, HEAD_DIM) for t in jnp.split(kv6, 6, axis=-1)]
    kc, ks, kw = rope(kc, pos), rope(ks, pos), rope(kw, pos)
    k_cmp = compress(kc, pe_k, w1_k, w2_k)
    v_cmp = compress(vc, pe_v, w1_v, w2_v)
    n_cmp = k_cmp.shape[1]
    cmp_start = jnp.arange(n_cmp) * B_CMP_STRIDE
    cmp_end = cmp_start + B_CMP_LEN - 1
    n_slc = S // B_SLC_LEN
    top_n = min(B_SLC_TOP, n_slc)
    ks_blk = jnp.transpose(ks.reshape(B, n_slc, B_SLC_LEN, B_GROUPS, HEAD_DIM), (0, 3, 1, 2, 4))
    vs_blk = jnp.transpose(vs.reshape(B, n_slc, B_SLC_LEN, B_GROUPS, HEAD_DIM), (0, 3, 1, 2, 4))
    slc_start = jnp.arange(n_slc) * B_SLC_LEN
    overlap = ((cmp_start[:, None] < slc_start[None, :] + B_SLC_LEN)
               & (slc_start[None, :] < cmp_start[:, None] + B_CMP_LEN)).astype(jnp.float32)
    jj = jnp.arange(n_slc)
    kw_pad = jnp.pad(kw, ((0, 0), (B_WINDOW, 0), (0, 0), (0, 0)))
    vw_pad = jnp.pad(vw, ((0, 0), (B_WINDOW, 0), (0, 0), (0, 0)))
    scale = HEAD_DIM ** -0.5

    def block(n):
        q0 = n * Q_BLOCK
        tq = q0 + jnp.arange(Q_BLOCK)
        qb = lax.dynamic_slice_in_dim(q, q0, Q_BLOCK, 1)
        s_c = jnp.einsum('bqgrd,bcgd->bgrqc', qb, k_cmp).astype(jnp.float32) * scale
        p_c = masked_softmax(s_c, cmp_end[None, :] <= tq[:, None])
        o_c = jnp.einsum('bgrqc,bcgd->bqgrd', p_c.astype(v_cmp.dtype), v_cmp)
        imp = jnp.einsum('bgrqc,cj->bgqj', p_c, overlap)
        blk_q = tq // B_SLC_LEN
        admissible = jj[None, :] <= blk_q[:, None]
        forced = (jj[None, :] == 0) | (jj[None, :] == blk_q[:, None]) | (jj[None, :] == blk_q[:, None] - 1)
        imp = jnp.where(admissible, imp + FORCE_BONUS * forced.astype(jnp.float32), NEG)
        _, sel = lax.top_k(imp, top_n)
        k_g = jax.vmap(gather_rows)(ks_blk, sel)
        v_g = jax.vmap(gather_rows)(vs_blk, sel).reshape(B, B_GROUPS, Q_BLOCK, top_n * B_SLC_LEN, HEAD_DIM)
        s_s = jnp.einsum('bqgrd,bgqnld->bgrqnl', qb, k_g).astype(jnp.float32) * scale
        s_s = s_s.reshape(B, B_GROUPS, B_REP, Q_BLOCK, top_n * B_SLC_LEN)
        tok = (sel[..., None] * B_SLC_LEN + jnp.arange(B_SLC_LEN)).reshape(B, B_GROUPS, Q_BLOCK, top_n * B_SLC_LEN)
        p_s = masked_softmax(s_s, (tok <= tq[None, None, :, None])[:, :, None])
        o_s = jnp.einsum('bgrqm,bgqmd->bqgrd', p_s.astype(v_g.dtype), v_g)
        kwin = lax.dynamic_slice_in_dim(kw_pad, q0, Q_BLOCK + B_WINDOW, 1)
        vwin = lax.dynamic_slice_in_dim(vw_pad, q0, Q_BLOCK + B_WINDOW, 1)
        kpos = q0 - B_WINDOW + jnp.arange(Q_BLOCK + B_WINDOW)
        mask_w = ((kpos[None, :] <= tq[:, None]) & (kpos[None, :] > tq[:, None] - B_WINDOW)
                  & (kpos[None, :] >= 0))
        s_w = jnp.einsum('bqgrd,bkgd->bgrqk', qb, kwin).astype(jnp.float32) * scale
        p_w = masked_softmax(s_w, mask_w)
        o_w = jnp.einsum('bgrqk,bkgd->bqgrd', p_w.astype(vwin.dtype), vwin)
        return o_c, o_s, o_w

    o_c, o_s, o_w = [jnp.moveaxis(o, 0, 1).reshape(B, S, B_GROUPS, B_REP, HEAD_DIM)
                     for o in lax.map(block, jnp.arange(S // Q_BLOCK))]
    g = jax.nn.sigmoid(gates.astype(jnp.float32)).astype(q.dtype).reshape(B, S, 3, B_GROUPS, B_REP, 1)
    o = g[:, :, 0] * o_c + g[:, :, 1] * o_s + g[:, :, 2] * o_w
    return o.reshape(B, S, B_WIDTH)


def setup_inputs(seed: int = 0) -> dict:
    key = jax.random.key(seed)
    ks = jax.random.split(key, 32)
    L = DEPTH

    def w(k, shape, fan_in, scale=1.0):
        return jax.random.normal(k, (L,) + shape, jnp.float32) * (scale * fan_in ** -0.5)

    def gain(k, n):
        return 1.0 + 0.02 * jax.random.normal(k, (L, n), jnp.float32)

    def bias(k, shape):
        return 0.02 * jax.random.normal(k, (L,) + shape, jnp.float32)

    D = D_MODEL
    return {
        "x": jax.random.normal(ks[0], (BATCH, SEQ, D), jnp.float32),
        "c": jax.random.normal(ks[1], (BATCH, D), jnp.float32),
        "w_ada": w(ks[2], (D, N_MOD * D), D),
        "b_ada": bias(ks[3], (N_MOD * D,)),
        "ffn1_w_in": w(ks[4], (D, 2 * D_FF), D),
        "ffn1_w_out": w(ks[5], (D_FF, D), D_FF, BETA),
        "ln1_g": gain(ks[6], D),
        "ln1_b": bias(ks[7], (D,)),
        "w_mix_in": w(ks[8], (D, MIX_IN_WIDTH), D),
        "kv_norm_g": gain(ks[9], A_KV_RANK),
        "w_kv_up": w(ks[10], (A_KV_RANK, 2 * HEAD_DIM), A_KV_RANK),
        "cmp_pe_k": 0.1 * jax.random.normal(ks[11], (L, B_CMP_LEN, HEAD_DIM), jnp.float32),
        "cmp_w1_k": w(ks[12], (B_CMP_LEN * HEAD_DIM, B_CMP_HIDDEN), B_CMP_LEN * HEAD_DIM),
        "cmp_w2_k": w(ks[13], (B_CMP_HIDDEN, HEAD_DIM), B_CMP_HIDDEN),
        "cmp_pe_v": 0.1 * jax.random.normal(ks[14], (L, B_CMP_LEN, HEAD_DIM), jnp.float32),
        "cmp_w1_v": w(ks[15], (B_CMP_LEN * HEAD_DIM, B_CMP_HIDDEN), B_CMP_LEN * HEAD_DIM),
        "cmp_w2_v": w(ks[16], (B_CMP_HIDDEN, HEAD_DIM), B_CMP_HIDDEN),
        "w_br_a": w(ks[17], (A_WIDTH, D), A_WIDTH),
        "w_br_b": w(ks[18], (B_WIDTH, D), B_WIDTH),
        "w_mix_out": w(ks[19], (D, D), D, BETA),
        "ln2_g": gain(ks[20], D),
        "ln2_b": bias(ks[21], (D,)),
        "ffn2_w_in": w(ks[22], (D, 2 * D_FF), D),
        "ffn2_w_out": w(ks[23], (D_FF, D), D_FF, BETA),
        "ln3_g": gain(ks[24], D),
        "ln3_b": bias(ks[25], (D,)),
    }


def reference(x, c, w_ada, b_ada, ffn1_w_in, ffn1_w_out, ln1_g, ln1_b, w_mix_in, kv_norm_g, w_kv_up,
              cmp_pe_k, cmp_w1_k, cmp_w2_k, cmp_pe_v, cmp_w1_v, cmp_w2_v, w_br_a, w_br_b, w_mix_out,
              ln2_g, ln2_b, ffn2_w_in, ffn2_w_out, ln3_g, ln3_b):
    S = x.shape[1]
    pos = jnp.arange(S)
    split_points = np.cumsum([A_WIDTH, A_KV_RANK, A_IDX_HEADS * A_IDX_DIM, A_IDX_DIM, A_IDX_HEADS,
                              B_WIDTH, 6 * B_KV_WIDTH, 3 * B_HEADS]).tolist()
    c_act = jax.nn.silu(c)
    for l in range(DEPTH):
        mod = c_act @ w_ada[l] + b_ada[l]
        sh1, sc1, g1, sh2, sc2, g2, sh3, sc3, g3 = jnp.split(mod, N_MOD, axis=-1)
        f1 = swiglu(modulate(x, sh1, sc1), ffn1_w_in[l], ffn1_w_out[l])
        x = layer_norm(ALPHA * x + 0.5 * g1[:, None, :] * f1, ln1_g[l], ln1_b[l])
        h = modulate(x, sh2, sc2) @ w_mix_in[l]
        qa, kv_lat, qi, ki, wi, qb, kv6, gb, gm = jnp.split(h, split_points, axis=-1)
        ya = dsa_mixer(qa, kv_lat, qi, ki, wi, kv_norm_g[l], w_kv_up[l], pos)
        yb = nsa_mixer(qb, kv6, gb, cmp_pe_k[l], cmp_w1_k[l], cmp_w2_k[l],
                       cmp_pe_v[l], cmp_w1_v[l], cmp_w2_v[l], pos)
        gate_a, gate_b = jnp.split(jax.nn.sigmoid(gm.astype(jnp.float32)).astype(x.dtype), 2, axis=-1)
        merged = gate_a * (ya @ w_br_a[l]) + gate_b * (yb @ w_br_b[l])
        mix = merged @ w_mix_out[l]
        x = layer_norm(ALPHA * x + g2[:, None, :] * mix, ln2_g[l], ln2_b[l])
        f2 = swiglu(modulate(x, sh3, sc3), ffn2_w_in[l], ffn2_w_out[l])
        x = layer_norm(ALPHA * x + 0.5 * g3[:, None, :] * f2, ln3_g[l], ln3_b[l])
    return x
```

```cpp
#include <hip/hip_runtime.h>
#include <hip/hip_cooperative_groups.h>
#include <cstdio>
#include <cmath>
namespace cg = cooperative_groups;

#define GAS __attribute__((address_space(1)))
#define LAS __attribute__((address_space(3)))
typedef unsigned short bf16_t;
typedef short bf16x8 __attribute__((ext_vector_type(8)));
typedef short s16x4 __attribute__((ext_vector_type(4)));
typedef _Float16 f16x8 __attribute__((ext_vector_type(8)));
typedef float f32x2 __attribute__((ext_vector_type(2)));
typedef float f32x4 __attribute__((ext_vector_type(4)));
typedef float f32x16 __attribute__((ext_vector_type(16)));
typedef unsigned u32x2 __attribute__((ext_vector_type(2)));
typedef unsigned u32x4 __attribute__((ext_vector_type(4)));
typedef GAS unsigned gu32;

#ifndef STAGE_LO
#define STAGE_LO 0
#endif
#ifndef STAGE_HI
#define STAGE_HI 16
#endif
#ifndef ONLY
#define ONLY -1
#endif
#define STG(n) (ONLY < 0 || ONLY == (n))
#ifndef FFN1_COEF
#define FFN1_COEF 0.5f
#endif
#ifndef FFN2_COEF
#define FFN2_COEF 0.5f
#endif
#ifndef DBG_NO_FFN
#define DBG_NO_FFN 0
#endif
#ifndef DBG_SKIP_MIXER
#define DBG_SKIP_MIXER 0
#endif

constexpr int NB = 8, SEQ = 4096, DM = 1024, MROWS = NB * SEQ, DFF = 2816, NFF = 2 * DFF, NMIX = 4352, NMOD = 9 * DM;
constexpr float ALPHA = 1.189207115002721f;
constexpr float LN_EPS = 1e-5f;
constexpr float QSCALE = 0.125f * 1.4426950408889634f;
constexpr int NWAVES = 8, NTHREADS = 512;
constexpr int LDS_BYTES = 163840;

constexpr size_t MiB = 1u << 20;
constexpr size_t WS_CTL = 0, CTL_ZERO_BYTES = 65536;
constexpr size_t WS_MODP = 1 * MiB;
constexpr size_t WS_MOD = 3 * MiB + 512 * 1024;
constexpr size_t WS_ROPE = 4 * MiB;
constexpr size_t WS_BIAS1P = 5 * MiB;
constexpr size_t WS_WKVUP = 5 * MiB + 64 * 1024;
constexpr size_t WS_WC2K = 5 * MiB + 128 * 1024;
constexpr size_t WS_WC2V = 5 * MiB + 192 * 1024;
constexpr size_t WS_W1IN = 6 * MiB, WS_W1OUT = 17 * MiB, WS_W2IN = 23 * MiB, WS_W2OUT = 34 * MiB, WS_WMIX = 40 * MiB;
constexpr size_t WS_WBRA = 49 * MiB, WS_WBRB = 50 * MiB, WS_WMO = 51 * MiB, WS_WC1K = 53 * MiB, WS_WC1V = 54 * MiB;
constexpr size_t WS_U = 56 * MiB;
constexpr size_t WS_XR = 120 * MiB;
constexpr size_t WS_HF = 248 * MiB;
constexpr size_t WS_GATE = 248 * MiB, WS_QA = 376 * MiB, WS_QI = 408 * MiB;
constexpr size_t WS_MASK = 424 * MiB;
constexpr size_t WS_KC = 440 * MiB, WS_VC = 448 * MiB, WS_KS = 456 * MiB, WS_VST = 464 * MiB, WS_KW = 472 * MiB, WS_VWT = 480 * MiB;
constexpr size_t WS_HIDK = 488 * MiB, WS_HIDV = 490 * MiB, WS_KI = 492 * MiB, WS_KA = 496 * MiB, WS_VAT = 500 * MiB, WS_KVL = 504 * MiB;
constexpr size_t WS_END = 512 * MiB;
constexpr size_t DO_QB = 0, DO_GB = 32 * MiB, DO_WI = 35 * MiB, DO_KCMP = 36 * MiB, DO_VCMPT = 37 * MiB, DO_T = 64 * MiB;
constexpr int CW_QSEL = 64, CW_QDSA = 128, CW_QNSA = 192, CW_BAR = 4096;

struct Args { const float* in[26]; float* out; unsigned char* ws; float inv_freq[32]; int ph_lo, ph_hi; };

__device__ __forceinline__ unsigned cvt_pk_bf16(float lo, float hi) { unsigned r; asm volatile("v_cvt_pk_bf16_f32 %0, %1, %2" : "=v"(r) : "v"(lo), "v"(hi)); return r; }
__device__ __forceinline__ unsigned cvt_pk_f16(float lo, float hi) { typedef _Float16 h2 __attribute__((ext_vector_type(2))); h2 v; v.x = (_Float16)lo; v.y = (_Float16)hi; return __builtin_bit_cast(unsigned, v); }
__device__ __forceinline__ float bf2f(unsigned short b) { return __uint_as_float(((unsigned)b) << 16); }
__device__ __forceinline__ float sigmoidf_(float x) { return 1.0f / (1.0f + __expf(-x)); }
__device__ __forceinline__ float siluf_(float x) { return x / (1.0f + __expf(-x)); }
__device__ __forceinline__ float wave_sum(float v) {
#pragma unroll
    for (int o = 1; o < 64; o <<= 1) v += __shfl_xor(v, o);
    return v;
}
#define LDS_WAIT() asm volatile("s_waitcnt lgkmcnt(0)" ::: "memory")
template <class T> __device__ __forceinline__ T* launder_ptr(T* p) {
    unsigned lo = (unsigned)(unsigned long long)p, hi = (unsigned)((unsigned long long)p >> 32);
    asm volatile("" : "+v"(lo), "+v"(hi));
    lo = (unsigned)__builtin_amdgcn_readfirstlane((int)lo); hi = (unsigned)__builtin_amdgcn_readfirstlane((int)hi);
    return (T*)(((unsigned long long)hi << 32) | (unsigned long long)lo);
}

namespace pg8 {
#define PG8_LAS __attribute__((address_space(3)))
constexpr int BM = 256, BK = 64, HALF = 128, HTB = HALF * BK * 2, STAGE_BYTES = 8 * HTB, NXCD = 8, WGM = 8;
__host__ __device__ __forceinline__ int lds_byte(int r, int c) { const int st = (r >> 4) * 2 + (c >> 5), rr = r & 15, cc = c & 31, ob = rr * 64 + cc * 2; return st * 1024 + (ob ^ (((ob >> 9) & 1) << 5)); }
__host__ __device__ __forceinline__ void stage_rc(int b, int& R, int& C) { const int st = b / 1024, sb = b % 1024, swz = sb ^ (((sb >> 9) & 1) << 5); R = (st >> 1) * 16 + swz / 64; C = (st & 1) * 32 + (swz % 64) / 2; }
__host__ __device__ __forceinline__ int perm32(int rho) { const int n = rho >> 4, i = rho & 15; return 8 * (i >> 2) + 4 * n + (i & 3); }
struct Unit { int pm, pn; };
struct Gemm { const bf16_t* A; const bf16_t* Bt; int M, N, K, lda; };
struct StaticOrder {
    int nM, nN, nwg, G, c;
    __host__ __device__ void init(int M, int N, int G_, int c_) { nM = M / BM; nN = N / BM; nwg = nM * nN; G = G_; c = c_; }
    __host__ __device__ bool next(int i, Unit& u) const {
        if (c < 0) return false;
        const long L = (long)i * G + c; if (L >= nwg) return false;
        int wgid = (int)L; { const int q = nwg / NXCD, r = nwg % NXCD, xcd = wgid % NXCD, off = wgid / NXCD; wgid = (xcd < r ? xcd * (q + 1) : r * (q + 1) + (xcd - r) * q) + off; }
        const int nig = WGM * nN, gid = wgid / nig, fm = gid * WGM, gsz = (nM - fm) < WGM ? (nM - fm) : WGM;
        u.pm = fm + ((wgid % nig) % gsz); u.pn = (wgid % nig) / gsz; return true;
    }
};
template <class Epi, class Sched>
__device__ __forceinline__ void gemm_phase(PG8_LAS unsigned char* lds, const Gemm g, const Sched& S, const Epi& E) {
    int tid = threadIdx.x; asm volatile("" : "+v"(tid));
    const int wid = __builtin_amdgcn_readfirstlane(tid >> 6), lane = tid & 63, wr = wid >> 2, wc = wid & 3, fr = lane & 15, fq = lane >> 4;
    const int K = g.K, nt = K / BK, lda = g.lda;
    unsigned voffA[2], voffB[2];
#pragma unroll
    for (int i = 0; i < 2; ++i) { int R, C; stage_rc(tid * 16 + i * 8192, R, C); const int Rb = Epi::PERM ? ((R & ~31) + perm32(R & 31)) : R;
        voffA[i] = (unsigned)(R * lda + C) * 2u; voffB[i] = (unsigned)(Rb * K + C) * 2u; }
    const size_t kstep = (size_t)(BK * 2);
    const size_t hstepA = (size_t)HALF * lda * 2, hstepB = (size_t)HALF * K * 2;
    const size_t tstepA = 2 * hstepA, tstepB = 2 * hstepB;
    const unsigned ldsw = (unsigned)wid * 1024u;
    const int aoff = lds_byte(wr * 64 + fr, fq * 8), boff = lds_byte(wc * 32 + fr, fq * 8);
#define PG8_SA(b, h) (((b) * 2 + (h)) * HTB)
#define PG8_SB(b, h) ((4 + (b) * 2 + (h)) * HTB)
#define PG8_STAGE(bufoff, gbase, voff) do { _Pragma("unroll") for (int _i = 0; _i < 2; ++_i) \
        __builtin_amdgcn_global_load_lds((const unsigned*)((const char*)(gbase) + (voff)[_i]), (PG8_LAS unsigned*)(lds + (bufoff) + ldsw + _i * 8192), 16, 0, 0); } while (0)
#define PG8_LDA(dst, b, h) do { _Pragma("unroll") for (int m = 0; m < 4; ++m) _Pragma("unroll") for (int k = 0; k < 2; ++k) dst[m][k] = *(const PG8_LAS bf16x8*)(lds + PG8_SA(b, h) + aoff + m * 2048 + k * 1024); } while (0)
#define PG8_LDB(dst, b, h) do { _Pragma("unroll") for (int n = 0; n < 2; ++n) _Pragma("unroll") for (int k = 0; k < 2; ++k) dst[n][k] = *(const PG8_LAS bf16x8*)(lds + PG8_SB(b, h) + boff + n * 2048 + k * 1024); } while (0)
#define PG8_MMA(ai, bj, At, Bt) do { __builtin_amdgcn_s_setprio(1); _Pragma("unroll") for (int m = 0; m < 4; ++m) _Pragma("unroll") for (int n = 0; n < 2; ++n) _Pragma("unroll") for (int k = 0; k < 2; ++k) \
        acc[ai][bj][m][n] = __builtin_amdgcn_mfma_f32_16x16x32_bf16(Bt[n][k], At[m][k], acc[ai][bj][m][n], 0, 0, 0); __builtin_amdgcn_s_setprio(0); } while (0)
#define PG8_WAIT_V(n) asm volatile("s_waitcnt vmcnt(" #n ")" ::: "memory")
#define PG8_WAIT_L(n) asm volatile("s_waitcnt lgkmcnt(" #n ")" ::: "memory")
#define PG8_BAR __builtin_amdgcn_s_barrier()
#define PG8_SCHED __builtin_amdgcn_sched_barrier(0)
    Unit cur, nxt; int ui = 0;
    if (!S.next(0, cur)) return;
    f32x4 acc[2][2][4][2];
#pragma unroll
    for (int a = 0; a < 2; ++a)
#pragma unroll
        for (int b = 0; b < 2; ++b)
#pragma unroll
            for (int m = 0; m < 4; ++m)
#pragma unroll
                for (int n = 0; n < 2; ++n) acc[a][b][m][n] = (f32x4){0.f, 0.f, 0.f, 0.f};
    bf16x8 At[4][2], B0[2][2], B1[2][2];
    const char* cA = (const char*)g.A + (size_t)cur.pm * tstepA; const char* cB = (const char*)g.Bt + (size_t)cur.pn * tstepB;
    PG8_STAGE(PG8_SB(0, 0), cB, voffB); PG8_STAGE(PG8_SB(0, 1), cB + hstepB, voffB); PG8_STAGE(PG8_SA(0, 0), cA, voffA); PG8_STAGE(PG8_SA(0, 1), cA + hstepA, voffA);
    if (wr == 1) PG8_BAR;
    PG8_WAIT_V(2); PG8_BAR;
    PG8_STAGE(PG8_SB(1, 0), cB + kstep, voffB); PG8_STAGE(PG8_SA(1, 0), cA + kstep, voffA); PG8_STAGE(PG8_SB(1, 1), cB + hstepB + kstep, voffB);
    PG8_WAIT_V(6); PG8_BAR;
    for (;;) {
        const bool has_next = S.next(ui + 1, nxt);
        const char* nA = has_next ? (const char*)g.A + (size_t)nxt.pm * tstepA : cA; const char* nB = has_next ? (const char*)g.Bt + (size_t)nxt.pn * tstepB : cB;
        for (int t = 0; t < nt; t += 2) {
            const bool last = (t == nt - 2);
            const char* a1 = cA + (size_t)(t + 1) * kstep;
            const char* a2 = last ? nA : cA + (size_t)(t + 2) * kstep; const char* b2 = last ? nB : cB + (size_t)(t + 2) * kstep;
            const char* a3 = a2 + kstep; const char* b3 = b2 + kstep;
            PG8_LDB(B0, 0, 0); PG8_LDB(B1, 0, 1); PG8_SCHED; PG8_LDA(At, 0, 0); PG8_STAGE(PG8_SA(1, 1), a1 + hstepA, voffA);
            PG8_WAIT_V(8); PG8_WAIT_L(0); PG8_BAR; PG8_MMA(0, 0, At, B0); PG8_MMA(0, 1, At, B1); PG8_BAR; PG8_SCHED;
            PG8_LDA(At, 0, 1); PG8_STAGE(PG8_SB(0, 0), b2, voffB); PG8_STAGE(PG8_SB(0, 1), b2 + hstepB, voffB); PG8_STAGE(PG8_SA(0, 0), a2, voffA);
            PG8_WAIT_V(8); PG8_WAIT_L(0); PG8_BAR; PG8_MMA(1, 0, At, B0); PG8_MMA(1, 1, At, B1); PG8_BAR; PG8_SCHED;
            PG8_LDB(B0, 1, 0); PG8_LDB(B1, 1, 1); PG8_SCHED; PG8_LDA(At, 1, 0); PG8_STAGE(PG8_SA(0, 1), a2 + hstepA, voffA);
            PG8_WAIT_V(8); PG8_WAIT_L(0); PG8_BAR; PG8_MMA(0, 0, At, B0); PG8_MMA(0, 1, At, B1); PG8_BAR; PG8_SCHED;
            PG8_LDA(At, 1, 1); PG8_STAGE(PG8_SB(1, 0), b3, voffB); PG8_STAGE(PG8_SB(1, 1), b3 + hstepB, voffB); PG8_STAGE(PG8_SA(1, 0), a3, voffA);
            PG8_WAIT_V(8); PG8_WAIT_L(0); PG8_BAR; PG8_MMA(1, 0, At, B0); PG8_MMA(1, 1, At, B1); PG8_BAR; PG8_SCHED;
        }
        if (wr == 0) PG8_BAR;
        E(acc, cur, wr, wc, fr, fq);
        if (!has_next) break;
#pragma unroll
        for (int a = 0; a < 2; ++a)
#pragma unroll
            for (int b = 0; b < 2; ++b)
#pragma unroll
                for (int m = 0; m < 4; ++m)
#pragma unroll
                    for (int n = 0; n < 2; ++n) acc[a][b][m][n] = (f32x4){0.f, 0.f, 0.f, 0.f};
        cur = nxt; cA = nA; cB = nB; ++ui;
        if (wr == 1) PG8_BAR;
    }
    PG8_WAIT_V(0);
    PG8_BAR;
#undef PG8_SA
#undef PG8_SB
#undef PG8_STAGE
#undef PG8_LDA
#undef PG8_LDB
#undef PG8_MMA
#undef PG8_WAIT_V
#undef PG8_WAIT_L
#undef PG8_BAR
#undef PG8_SCHED
}
}

struct EpiSwiglu {
    static constexpr bool PERM = true;
    bf16_t* O;
    __device__ __forceinline__ void operator()(const f32x4 (&acc)[2][2][4][2], const pg8::Unit& u, int wr, int wc, int fr, int fq) const {
        asm volatile("" : "+v"(fr), "+v"(fq));
        const int row0 = u.pm * 256 + wr * 64 + fr, col0 = u.pn * 128 + wc * 32 + 8 * fq;
#pragma unroll
        for (int ai = 0; ai < 2; ++ai)
#pragma unroll
            for (int m = 0; m < 4; ++m) {
                bf16_t* rowp = O + (size_t)(row0 + ai * 128 + m * 16) * DFF + col0;
                float h[8];
#pragma unroll
                for (int n = 0; n < 2; ++n)
#pragma unroll
                    for (int j = 0; j < 4; ++j) h[n * 4 + j] = siluf_(acc[ai][0][m][n][j]) * acc[ai][1][m][n][j];
                u32x4 w; w.x = cvt_pk_bf16(h[0], h[1]); w.y = cvt_pk_bf16(h[2], h[3]); w.z = cvt_pk_bf16(h[4], h[5]); w.w = cvt_pk_bf16(h[6], h[7]);
                *(u32x4*)rowp = w;
            }
    }
};
struct EpiResid {
    static constexpr bool PERM = false;
    const float* xres; const float* gmod; float* Y; float coef;
    __device__ __forceinline__ void operator()(const f32x4 (&acc)[2][2][4][2], const pg8::Unit& u, int wr, int wc, int fr, int fq) const {
        asm volatile("" : "+v"(fr), "+v"(fq));
        const int row0 = u.pm * 256 + wr * 64 + fr, col0 = u.pn * 256 + wc * 32 + 4 * fq, b = u.pm >> 4;
        const float* gp = gmod + (size_t)b * NMOD + col0;
#pragma unroll
        for (int bj = 0; bj < 2; ++bj)
#pragma unroll
            for (int n = 0; n < 2; ++n) {
                const f32x4 gv = *(const f32x4*)(gp + bj * 128 + n * 16) * coef;
#pragma unroll
                for (int ai = 0; ai < 2; ++ai) {
#pragma unroll
                    for (int m = 0; m < 4; ++m) {
                        const size_t off = (size_t)(row0 + ai * 128 + m * 16) * DM + col0 + bj * 128 + n * 16;
                        const f32x4 xr = *(const f32x4*)(xres + off);
                        *(f32x4*)(Y + off) = xr * ALPHA + gv * acc[ai][bj][m][n];
                    }
                    asm volatile("" ::: "memory");
                }
            }
    }
};
struct EpiGate {
    static constexpr bool PERM = true;
    const bf16_t* gate; int gcol0; const bf16_t* addsrc; bf16_t* O;
    __device__ __forceinline__ void operator()(const f32x4 (&acc)[2][2][4][2], const pg8::Unit& u, int wr, int wc, int fr, int fq) const {
        asm volatile("" : "+v"(fr), "+v"(fq));
        const int row0 = u.pm * 256 + wr * 64 + fr, col0 = u.pn * 256 + wc * 32 + 8 * fq;
#pragma unroll
        for (int ai = 0; ai < 2; ++ai)
#pragma unroll
            for (int m = 0; m < 4; ++m) {
                const size_t row = (size_t)(row0 + ai * 128 + m * 16);
#pragma unroll
                for (int bj = 0; bj < 2; ++bj) {
                    const int c = col0 + bj * 128;
                    const u32x4 gw = *(const u32x4*)(gate + row * 2048 + gcol0 + c);
                    float v[8];
#pragma unroll
                    for (int n = 0; n < 2; ++n)
#pragma unroll
                        for (int j = 0; j < 4; ++j) v[n * 4 + j] = acc[ai][bj][m][n][j];
#pragma unroll
                    for (int q = 0; q < 4; ++q) { v[2 * q] *= __uint_as_float(gw[q] << 16); v[2 * q + 1] *= __uint_as_float(gw[q] & 0xffff0000u); }
                    if (addsrc) { const u32x4 aw = *(const u32x4*)(addsrc + row * DM + c);
#pragma unroll
                        for (int q = 0; q < 4; ++q) { v[2 * q] += __uint_as_float(aw[q] << 16); v[2 * q + 1] += __uint_as_float(aw[q] & 0xffff0000u); } }
                    u32x4 w; w.x = cvt_pk_bf16(v[0], v[1]); w.y = cvt_pk_bf16(v[2], v[3]); w.z = cvt_pk_bf16(v[4], v[5]); w.w = cvt_pk_bf16(v[6], v[7]);
                    *(u32x4*)(O + row * DM + c) = w;
                }
                asm volatile("" ::: "memory");
            }
    }
};
struct EpiCmp1 {
    static constexpr bool PERM = true;
    unsigned char* ws; int kv;
    __device__ __forceinline__ void operator()(const f32x4 (&acc)[2][2][4][2], const pg8::Unit& u, int wr, int wc, int fr, int fq) const {
        asm volatile("" : "+v"(fr), "+v"(fq));
        unsigned char* w_ = launder_ptr(ws);
        const float* bias1p = (const float*)(w_ + WS_BIAS1P) + (kv ? 8 * 256 : 0); bf16_t* O = (bf16_t*)(w_ + (kv ? WS_HIDV : WS_HIDK));
        const int row0 = u.pm * 256 + wr * 64 + fr, col0 = wc * 32 + 8 * fq;
        float bv[2][8];
#pragma unroll
        for (int bj = 0; bj < 2; ++bj)
#pragma unroll
            for (int e = 0; e < 8; ++e) { float s = 0.f;
#pragma unroll
                for (int kc = 0; kc < 8; ++kc) s += bias1p[kc * 256 + col0 + bj * 128 + e];
                bv[bj][e] = s; }
#pragma unroll
        for (int ai = 0; ai < 2; ++ai)
#pragma unroll
            for (int m = 0; m < 4; ++m) {
                const size_t row = (size_t)(row0 + ai * 128 + m * 16);
#pragma unroll
                for (int bj = 0; bj < 2; ++bj) {
                    float v[8];
#pragma unroll
                    for (int n = 0; n < 2; ++n)
#pragma unroll
                        for (int j = 0; j < 4; ++j) v[n * 4 + j] = siluf_(acc[ai][bj][m][n][j] + bv[bj][n * 4 + j]);
                    u32x4 w; w.x = cvt_pk_bf16(v[0], v[1]); w.y = cvt_pk_bf16(v[2], v[3]); w.z = cvt_pk_bf16(v[4], v[5]); w.w = cvt_pk_bf16(v[6], v[7]);
                    *(u32x4*)(O + row * 256 + col0 + bj * 128) = w;
                }
            }
    }
};
struct EpiMix {
    static constexpr bool PERM = true;
    unsigned char* ws_m; unsigned char* dout_m;
    __device__ __forceinline__ void operator()(const f32x4 (&acc)[2][2][4][2], const pg8::Unit& u, int wr, int wc, int fr, int fq) const {
        asm volatile("" : "+v"(fr), "+v"(fq));
        unsigned char* ws = launder_ptr(ws_m); unsigned char* dout = launder_ptr(dout_m);
        const f32x2* rope = (const f32x2*)(ws + WS_ROPE);
        const int slot = u.pn * 4 + wc, b = u.pm >> 4;
        const int t0 = (u.pm & 15) * 256 + wr * 64 + fr;
        int kind;
        bool rope_on = false, f16o = false, sig = false; float scale = 1.f;
        unsigned short* dst = nullptr; int ld = 0, col0 = 0;
        if (slot < 8)       { kind = 0; rope_on = true; scale = QSCALE; dst = (unsigned short*)(ws + WS_QA) + (size_t)b * SEQ * 512; ld = 512; col0 = 64 * slot; }
        else if (slot < 12) { kind = 0; rope_on = true; f16o = true; dst = (unsigned short*)(ws + WS_QI) + (size_t)b * SEQ * 256; ld = 256; col0 = 64 * (slot - 8); }
        else if (slot < 20) { kind = 0; rope_on = true; scale = QSCALE; dst = (unsigned short*)(dout + DO_QB) + (size_t)b * SEQ * 512; ld = 512; col0 = 64 * (slot - 12); }
        else if (slot < 26) { kind = 0; rope_on = true; const int w = (slot - 20) >> 1, g = (slot - 20) & 1;
                              dst = (unsigned short*)(ws + (w == 0 ? WS_KC : (w == 1 ? WS_KS : WS_KW))) + (size_t)(b * 2 + g) * SEQ * 64; ld = 64; col0 = 0; }
        else if (slot == 26) { kind = 0; rope_on = true; f16o = true; dst = (unsigned short*)(ws + WS_KI) + (size_t)b * SEQ * 64; ld = 64; col0 = 0; }
        else if (slot == 27) { kind = 2; }
        else if (slot < 30) { kind = 0; dst = (unsigned short*)(ws + WS_VC) + (size_t)(b * 2 + (slot - 28)) * SEQ * 64; ld = 64; col0 = 0; }
        else if (slot < 34) { kind = 1; const int w = (slot - 30) >> 1, g = (slot - 30) & 1; dst = (unsigned short*)(ws + (w == 0 ? WS_VST : WS_VWT)) + (size_t)(b * 2 + g) * 64 * SEQ; }
        else if (slot < 36) { kind = 0; dst = (unsigned short*)(ws + WS_KVL) + (size_t)b * SEQ * 128; ld = 128; col0 = 64 * (slot - 34); }
        else                { kind = 0; sig = true; dst = (unsigned short*)(ws + WS_GATE) + (size_t)b * SEQ * 2048; ld = 2048; col0 = 64 * (slot - 36); }
        if (kind == 0) {
#pragma unroll
            for (int ai = 0; ai < 2; ++ai)
#pragma unroll
                for (int m = 0; m < 4; ++m) {
                    const int t = t0 + ai * 128 + m * 16;
                    float x1[8], x2[8];
#pragma unroll
                    for (int n = 0; n < 2; ++n)
#pragma unroll
                        for (int j = 0; j < 4; ++j) { x1[n * 4 + j] = acc[ai][0][m][n][j]; x2[n * 4 + j] = acc[ai][1][m][n][j]; }
                    if (rope_on) {
                        const f32x4* rp = (const f32x4*)(rope + (size_t)t * 32 + 8 * fq);
#pragma unroll
                        for (int q = 0; q < 4; ++q) { const f32x4 cs = rp[q];
                            const float a0 = x1[2 * q], b0 = x2[2 * q], a1 = x1[2 * q + 1], b1 = x2[2 * q + 1];
                            x1[2 * q] = (a0 * cs[0] - b0 * cs[1]) * scale; x2[2 * q] = (a0 * cs[1] + b0 * cs[0]) * scale;
                            x1[2 * q + 1] = (a1 * cs[2] - b1 * cs[3]) * scale; x2[2 * q + 1] = (a1 * cs[3] + b1 * cs[2]) * scale; }
                    }
                    if (sig) {
#pragma unroll
                        for (int e = 0; e < 8; ++e) { x1[e] = sigmoidf_(x1[e]); x2[e] = sigmoidf_(x2[e]); }
                    }
                    u32x4 w1, w2;
                    if (f16o) { w1.x = cvt_pk_f16(x1[0], x1[1]); w1.y = cvt_pk_f16(x1[2], x1[3]); w1.z = cvt_pk_f16(x1[4], x1[5]); w1.w = cvt_pk_f16(x1[6], x1[7]);
                                w2.x = cvt_pk_f16(x2[0], x2[1]); w2.y = cvt_pk_f16(x2[2], x2[3]); w2.z = cvt_pk_f16(x2[4], x2[5]); w2.w = cvt_pk_f16(x2[6], x2[7]); }
                    else      { w1.x = cvt_pk_bf16(x1[0], x1[1]); w1.y = cvt_pk_bf16(x1[2], x1[3]); w1.z = cvt_pk_bf16(x1[4], x1[5]); w1.w = cvt_pk_bf16(x1[6], x1[7]);
                                w2.x = cvt_pk_bf16(x2[0], x2[1]); w2.y = cvt_pk_bf16(x2[2], x2[3]); w2.z = cvt_pk_bf16(x2[4], x2[5]); w2.w = cvt_pk_bf16(x2[6], x2[7]); }
                    unsigned short* rowp = dst + (size_t)t * ld + col0 + 8 * fq;
                    *(u32x4*)rowp = w1; *(u32x4*)(rowp + 32) = w2;
                    asm volatile("" ::: "memory");
                }
        } else if (kind == 1) {
#pragma unroll
            for (int ai = 0; ai < 2; ++ai)
#pragma unroll
                for (int m = 0; m < 4; ++m) {
                    const int t = t0 + ai * 128 + m * 16;
#pragma unroll
                    for (int bj = 0; bj < 2; ++bj)
#pragma unroll
                        for (int n = 0; n < 2; ++n)
#pragma unroll
                            for (int j = 0; j < 4; ++j) { const int d = 32 * bj + 8 * fq + 4 * n + j;
                                dst[(size_t)d * SEQ + t] = (unsigned short)(cvt_pk_bf16(acc[ai][bj][m][n][j], 0.f) & 0xffffu); }
                }
        } else {
            float* WI = (float*)(dout + DO_WI) + (size_t)b * SEQ * 4; float* GB = (float*)(dout + DO_GB) + (size_t)b * SEQ * 24;
#pragma unroll
            for (int ai = 0; ai < 2; ++ai)
#pragma unroll
                for (int m = 0; m < 4; ++m) {
                    const int t = t0 + ai * 128 + m * 16;
#pragma unroll
                    for (int n = 0; n < 2; ++n) { const int e0 = 8 * fq + 4 * n; const f32x4 v = acc[ai][0][m][n];
                        if (e0 == 0) { *(f32x4*)(WI + (size_t)t * 4) = v * 0.5f; }
                        else if (e0 < 28) { f32x4 s; s[0] = sigmoidf_(v[0]); s[1] = sigmoidf_(v[1]); s[2] = sigmoidf_(v[2]); s[3] = sigmoidf_(v[3]); *(f32x4*)(GB + (size_t)t * 24 + (e0 - 4)) = s; } }
                }
        }
    }
};

struct AttnAcc { f32x16 o0, o1; float m, l; };
__device__ __forceinline__ void attn_init(AttnAcc& A) {
#pragma unroll
    for (int r = 0; r < 16; ++r) { A.o0[r] = 0.f; A.o1[r] = 0.f; }
    A.m = -1e30f; A.l = 0.f;
}
__device__ __forceinline__ void attn_step(AttnAcc& A, const bf16x8 (&qf)[4], const bf16_t* __restrict__ Kp, const bf16_t* __restrict__ VTp, int ldv, unsigned vmask, int hi) {
    f32x16 s;
#pragma unroll
    for (int r = 0; r < 16; ++r) s[r] = 0.f;
#pragma unroll
    for (int ks = 0; ks < 4; ++ks) { const bf16x8 kf = *(const bf16x8*)(Kp + ks * 16); s = __builtin_amdgcn_mfma_f32_32x32x16_bf16(kf, qf[ks], s, 0, 0, 0); }
    s16x4 vf[2][2][2];
#pragma unroll
    for (int dt = 0; dt < 2; ++dt)
#pragma unroll
        for (int st = 0; st < 2; ++st) { vf[dt][st][0] = *(const s16x4*)(VTp + (size_t)dt * 32 * ldv + st * 16); vf[dt][st][1] = *(const s16x4*)(VTp + (size_t)dt * 32 * ldv + st * 16 + 8); }
    float mx = -INFINITY;
#pragma unroll
    for (int r = 0; r < 16; ++r) { const int ko = (r & 3) + 8 * (r >> 2) + 4 * hi; if (!((vmask >> ko) & 1u)) s[r] = -INFINITY; mx = fmaxf(mx, s[r]); }
    mx = fmaxf(mx, __shfl_xor(mx, 32));
    const float mn = fmaxf(A.m, mx), alpha = __builtin_amdgcn_exp2f(A.m - mn); A.m = mn;
    float ls = 0.f;
#pragma unroll
    for (int r = 0; r < 16; ++r) { s[r] = __builtin_amdgcn_exp2f(s[r] - mn); ls += s[r]; }
    A.l = A.l * alpha + ls;
#pragma unroll
    for (int r = 0; r < 16; ++r) { A.o0[r] *= alpha; A.o1[r] *= alpha; }
    u32x4 p0, p1;
    p0.x = cvt_pk_bf16(s[0], s[1]); p0.y = cvt_pk_bf16(s[2], s[3]); p0.z = cvt_pk_bf16(s[4], s[5]); p0.w = cvt_pk_bf16(s[6], s[7]);
    p1.x = cvt_pk_bf16(s[8], s[9]); p1.y = cvt_pk_bf16(s[10], s[11]); p1.z = cvt_pk_bf16(s[12], s[13]); p1.w = cvt_pk_bf16(s[14], s[15]);
    const bf16x8 pb0 = __builtin_bit_cast(bf16x8, p0), pb1 = __builtin_bit_cast(bf16x8, p1);
#define VFR(dt, st) (bf16x8){vf[dt][st][0][0], vf[dt][st][0][1], vf[dt][st][0][2], vf[dt][st][0][3], vf[dt][st][1][0], vf[dt][st][1][1], vf[dt][st][1][2], vf[dt][st][1][3]}
    A.o0 = __builtin_amdgcn_mfma_f32_32x32x16_bf16(VFR(0, 0), pb0, A.o0, 0, 0, 0);
    A.o0 = __builtin_amdgcn_mfma_f32_32x32x16_bf16(VFR(0, 1), pb1, A.o0, 0, 0, 0);
    A.o1 = __builtin_amdgcn_mfma_f32_32x32x16_bf16(VFR(1, 0), pb0, A.o1, 0, 0, 0);
    A.o1 = __builtin_amdgcn_mfma_f32_32x32x16_bf16(VFR(1, 1), pb1, A.o1, 0, 0, 0);
#undef VFR
}
__device__ __forceinline__ float attn_inv_l(const AttnAcc& A) { const float l = A.l + __shfl_xor(A.l, 32); return l > 0.f ? 1.0f / l : 0.f; }
__device__ __forceinline__ void attn_store(const f32x16& o0, const f32x16& o1, bf16_t* yrow  , int hi) {
#pragma unroll
    for (int k4 = 0; k4 < 4; ++k4) {
        u32x2 w0, w1;
        w0.x = cvt_pk_bf16(o0[4 * k4], o0[4 * k4 + 1]); w0.y = cvt_pk_bf16(o0[4 * k4 + 2], o0[4 * k4 + 3]);
        w1.x = cvt_pk_bf16(o1[4 * k4], o1[4 * k4 + 1]); w1.y = cvt_pk_bf16(o1[4 * k4 + 2], o1[4 * k4 + 3]);
        *(u32x2*)(yrow + 8 * k4 + 4 * hi) = w0; *(u32x2*)(yrow + 32 + 8 * k4 + 4 * hi) = w1;
    }
}

#define XB_TMO      128
#define XB_XCNT(j)  (256  + 64 * (j))
#define XB_XSUB(j)  (1280 + 64 * (j))
#define XB_XGEN(j)  (2304 + 64 * (j))
#define XB_TOP      3328
#define XB_TOPGEN   3392
#define XCD_BAR_WORDS 3456
#define XB_SPIN_CAP (1u << 18)

__device__ __forceinline__ unsigned xb_ld(unsigned* p)              { return __hip_atomic_load(p, __ATOMIC_RELAXED, __HIP_MEMORY_SCOPE_AGENT); }
__device__ __forceinline__ unsigned xb_add(unsigned* p, unsigned v) { return __hip_atomic_fetch_add(p, v, __ATOMIC_RELAXED, __HIP_MEMORY_SCOPE_AGENT); }
__device__ __forceinline__ unsigned xb_xcc_id() { return (unsigned)__builtin_amdgcn_s_getreg((3 << 11) | 20) & 0xFu; }
#define XB_SPIN(cond, bar) do { unsigned _sp = 0; while (cond) { __builtin_amdgcn_s_sleep(1); \
    if ((++_sp & 255u) == 0u) { if (xb_ld(&(bar)[XB_TMO])) break; if (_sp > XB_SPIN_CAP) { atomicAdd(&(bar)[XB_TMO], 1u); break; } } } } while (0)

struct XcdBarrier {
    unsigned* bar; unsigned x;
    volatile LAS unsigned* st;
};

__device__ __forceinline__ XcdBarrier xcd_barrier_post(unsigned* bar, volatile LAS unsigned* st) {
    XcdBarrier b; b.bar = bar; b.x = xb_xcc_id(); b.st = st;
    if (threadIdx.x == 0) (void)xb_add(&bar[XB_XCNT(b.x)], 1u);
    return b;
}
__device__ __forceinline__ void xcd_barrier_complete(unsigned* bar, unsigned x, unsigned& nloc, unsigned& nx) {
    const unsigned G = gridDim.x * gridDim.y * gridDim.z;
    unsigned sum, cnt, mine, sp = 0u;
    for (;;) {
        sum = 0u; cnt = 0u; mine = 0u;
#pragma unroll
        for (unsigned j = 0; j < 16; ++j) { const unsigned c = xb_ld(&bar[XB_XCNT(j)]); sum += c; cnt += (c > 0u) ? 1u : 0u; mine = (j == x) ? c : mine; }
        if (sum == G) break;
        __builtin_amdgcn_s_sleep(1);
        if ((++sp & 255u) == 0u) { if (xb_ld(&bar[XB_TMO])) break; if (sp > XB_SPIN_CAP) { atomicAdd(&bar[XB_TMO], 1u); break; } }
    }
    nloc = mine > 0u ? mine : 1u; nx = cnt > 0u ? cnt : 1u;
}

__device__ __forceinline__ void xcd_barrier(const XcdBarrier& b) {
    asm volatile("s_waitcnt vmcnt(0)" ::: "memory");
    __syncthreads();
    if (threadIdx.x == 0) {
        unsigned* bar = b.bar;
        __builtin_amdgcn_s_waitcnt(0);
        unsigned nloc = b.st[0], nx = b.st[1];
        if (nloc == 0u) { xcd_barrier_complete(bar, b.x, nloc, nx); b.st[0] = nloc; b.st[1] = nx; }
        const unsigned old = xb_add(&bar[XB_XSUB(b.x)], 1u);
        const unsigned gen = old / nloc;
        if (old + 1u == (gen + 1u) * nloc) {
            __builtin_amdgcn_fence(__ATOMIC_RELEASE, "agent");
            asm volatile("s_waitcnt vmcnt(0)" ::: "memory");
            const unsigned og = xb_add(&bar[XB_TOP], 1u);
            const unsigned tg = og / nx;
            if (og + 1u == (tg + 1u) * nx) xb_add(&bar[XB_TOPGEN], 1u);
            else XB_SPIN(xb_ld(&bar[XB_TOPGEN]) == tg, bar);
            __builtin_amdgcn_fence(__ATOMIC_ACQUIRE, "agent");
            xb_add(&bar[XB_XGEN(b.x)], 1u);
            asm volatile("s_waitcnt vmcnt(0)" ::: "memory");
        } else {
            XB_SPIN(xb_ld(&bar[XB_XGEN(b.x)]) == gen, bar);
            __builtin_amdgcn_fence(__ATOMIC_ACQUIRE, "agent");
            asm volatile("s_waitcnt vmcnt(0)" ::: "memory");
        }
    }
    __syncthreads();
}

struct Frame {
    LAS unsigned char* lds; unsigned char* ws; unsigned char* dout; const float* const* in;
    int tid, lane, wave, G, blk;
};

__device__ __forceinline__ void transpose_item(const float* W, int K, int N, bf16_t* WT, int k0, int srccol, int dst_row0, LAS float* scr, int lane, const float* kscale) {
#pragma unroll 8
    for (int i = 0; i < 32; ++i) { const int kk = 2 * i + (lane >> 5); float v = 0.f; if (srccol >= 0) v = W[(size_t)(k0 + kk) * N + srccol]; if (kscale) v *= kscale[k0 + kk]; scr[kk * 33 + (lane & 31)] = v; }
    LDS_WAIT(); asm volatile("" ::: "memory");
    const int c = lane & 7;
#pragma unroll
    for (int j = 0; j < 4; ++j) { const int n = (lane >> 3) + 8 * j; const LAS float* s = scr + (8 * c) * 33 + n;
        u32x4 o; o.x = cvt_pk_bf16(s[0 * 33], s[1 * 33]); o.y = cvt_pk_bf16(s[2 * 33], s[3 * 33]); o.z = cvt_pk_bf16(s[4 * 33], s[5 * 33]); o.w = cvt_pk_bf16(s[6 * 33], s[7 * 33]);
        *(u32x4*)(WT + (size_t)(dst_row0 + n) * K + k0 + 8 * c) = o; }
    LDS_WAIT(); asm volatile("" ::: "memory");
}
__device__ __forceinline__ int mix_srccol(int slot, int bj, int e) {
    int base;
    if (slot < 8) base = 0 + 64 * slot;
    else if (slot < 12) base = 640 + 64 * (slot - 8);
    else if (slot < 20) base = 964 + 64 * (slot - 12);
    else if (slot < 22) base = 1476 + 64 * (slot - 20);
    else if (slot < 24) base = 1732 + 64 * (slot - 22);
    else if (slot < 26) base = 1988 + 64 * (slot - 24);
    else if (slot == 26) base = 896;
    else if (slot == 27) { if (bj == 1) return -1; if (e < 4) return 960 + e; if (e < 28) return 2244 + (e - 4); return -1; }
    else if (slot < 30) base = 1604 + 64 * (slot - 28);
    else if (slot < 32) base = 1860 + 64 * (slot - 30);
    else if (slot < 34) base = 2116 + 64 * (slot - 32);
    else if (slot < 36) base = 512 + 64 * (slot - 34);
    else base = 2268 + 64 * (slot - 36);
    return base + 32 * bj + e;
}
__device__ __forceinline__ void sincos_d(double x, float& sn, float& cs) {
    const double n = rint(x * 0.6366197723675814);
    double r = fma(-n, 1.5707963267341256, x); r = fma(-n, 6.077100506506192e-11, r);
    const double r2 = r * r;
    double sp = -7.647163731819816e-13; sp = fma(sp, r2, 1.6059043836821613e-10); sp = fma(sp, r2, -2.505210838544172e-08); sp = fma(sp, r2, 2.7557319223985893e-06);
    sp = fma(sp, r2, -0.0001984126984126984); sp = fma(sp, r2, 0.008333333333333333); sp = fma(sp, r2, -0.16666666666666666); sp = fma(sp * r2, r, r);
    double cp = 4.779477332387385e-14; cp = fma(cp, r2, -1.1470745597729725e-11); cp = fma(cp, r2, 2.08767569878681e-09); cp = fma(cp, r2, -2.755731922398589e-07);
    cp = fma(cp, r2, 2.48015873015873e-05); cp = fma(cp, r2, -0.001388888888888889); cp = fma(cp, r2, 0.041666666666666664); cp = fma(cp, r2, -0.5); cp = fma(cp, r2, 1.0);
    const int q = ((int)n) & 3;
    const double s_ = (q & 1) ? cp : sp, c_ = (q & 1) ? sp : cp;
    sn = (float)((q & 2) ? -s_ : s_); cs = (float)(((q + 1) & 2) ? -c_ : c_);
}

__device__ __forceinline__ void stage_prologue(Frame& F, const Args& args) {
    LAS float* scr = (LAS float*)(F.lds + F.wave * 8448);
    LAS float* cact = (LAS float*)(F.lds + 69632);
    const float* cin = F.in[1];
    for (int i = F.tid; i < NB * DM; i += NTHREADS) cact[i] = siluf_(cin[i]);
    __syncthreads();
    const int gw = F.blk * NWAVES + F.wave, NGW = F.G * NWAVES;
    {
        const float* wada = F.in[2]; float* modp = (float*)(F.ws + WS_MODP);
        for (int it = gw; it < 144 * 8; it += NGW) {
            const int cgp = it % 144, kc = it / 144, n = cgp * 64 + F.lane;
            float a[8];
#pragma unroll
            for (int b = 0; b < 8; ++b) a[b] = 0.f;
#pragma unroll 8
            for (int k = kc * 128; k < kc * 128 + 128; ++k) { const float w = wada[(size_t)k * NMOD + n];
#pragma unroll
                for (int b = 0; b < 8; ++b) a[b] += cact[b * DM + k] * w; }
#pragma unroll
            for (int b = 0; b < 8; ++b) modp[((size_t)kc * 8 + b) * NMOD + n] = a[b];
        }
    }
    {
        float* b1p = (float*)(F.ws + WS_BIAS1P);
        for (int it = gw; it < 64; it += NGW) {
            const int kv = it >> 5, cgp = (it >> 3) & 3, kc = it & 7, n = cgp * 64 + F.lane;
            const float* pe = F.in[kv ? 14 : 11]; const float* w1 = F.in[kv ? 15 : 12];
            float a = 0.f;
#pragma unroll 8
            for (int k = kc * 256; k < kc * 256 + 256; ++k) a += pe[k] * w1[(size_t)k * 256 + n];
            b1p[(kv * 8 + kc) * 256 + n] = a;
        }
    }
    {
        f32x2* rope = (f32x2*)(F.ws + WS_ROPE);
        for (int i = F.blk * NTHREADS + F.tid; i < SEQ * 32; i += F.G * NTHREADS) {
            const int pos = i >> 5, d = i & 31; const float ang = (float)pos * args.inv_freq[d];
            float sn, cs; sincos_d((double)ang, sn, cs); rope[i] = (f32x2){cs, sn};
        }
    }
    {
        constexpr int I_FIN = 16 * 176, I_FOUT = 44 * 32, I_MIX = 16 * 136, I_BR = 8 * 32, I_MO = 16 * 32, I_C1 = 32 * 8, I_C2 = 4 * 2, I_KV = 2 * 4;
        constexpr int NITEMS = 2 * I_FIN + 2 * I_FOUT + I_MIX + 2 * I_BR + I_MO + 2 * I_C1 + 2 * I_C2 + I_KV;
        for (int it = gw; it < NITEMS; it += NGW) {
            int r = it; const int l31 = F.lane & 31;
            if (r < 2 * I_FIN) { const int w = r / I_FIN; r -= w * I_FIN; const int kb = r / 176, ng = r % 176;
                const int pn = ng >> 3, half = (ng >> 2) & 1, sub = ng & 3; const int src = half * DFF + pn * 128 + sub * 32 + l31;
                transpose_item(F.in[w ? 22 : 4], DM, NFF, (bf16_t*)(F.ws + (w ? WS_W2IN : WS_W1IN)), 64 * kb, src, 32 * ng, scr, F.lane, nullptr); continue; }
            r -= 2 * I_FIN;
            if (r < 2 * I_FOUT) { const int w = r / I_FOUT; r -= w * I_FOUT; const int kb = r / 32, ng = r % 32;
                transpose_item(F.in[w ? 23 : 5], DFF, DM, (bf16_t*)(F.ws + (w ? WS_W2OUT : WS_W1OUT)), 64 * kb, 32 * ng + l31, 32 * ng, scr, F.lane, nullptr); continue; }
            r -= 2 * I_FOUT;
            if (r < I_MIX) { const int kb = r / 136, ng = r % 136; const int pn = ng >> 3, bj = (ng >> 2) & 1, wc = ng & 3;
                transpose_item(F.in[8], DM, 4316, (bf16_t*)(F.ws + WS_WMIX), 64 * kb, mix_srccol(pn * 4 + wc, bj, l31), 32 * ng, scr, F.lane, nullptr); continue; }
            r -= I_MIX;
            if (r < 2 * I_BR) { const int w = r / I_BR; r -= w * I_BR; const int kb = r / 32, ng = r % 32;
                transpose_item(F.in[w ? 18 : 17], 512, DM, (bf16_t*)(F.ws + (w ? WS_WBRB : WS_WBRA)), 64 * kb, 32 * ng + l31, 32 * ng, scr, F.lane, nullptr); continue; }
            r -= 2 * I_BR;
            if (r < I_MO) { const int kb = r / 32, ng = r % 32;
                transpose_item(F.in[19], DM, DM, (bf16_t*)(F.ws + WS_WMO), 64 * kb, 32 * ng + l31, 32 * ng, scr, F.lane, nullptr); continue; }
            r -= I_MO;
            if (r < 2 * I_C1) { const int w = r / I_C1; r -= w * I_C1; const int kb = r / 8, ng = r % 8;
                transpose_item(F.in[w ? 15 : 12], 2048, 256, (bf16_t*)(F.ws + (w ? WS_WC1V : WS_WC1K)), 64 * kb, 32 * ng + l31, 32 * ng, scr, F.lane, nullptr); continue; }
            r -= 2 * I_C1;
            if (r < 2 * I_C2) { const int w = r / I_C2; r -= w * I_C2; const int kb = r / 2, ng = r % 2;
                transpose_item(F.in[w ? 16 : 13], 256, 64, (bf16_t*)(F.ws + (w ? WS_WC2V : WS_WC2K)), 64 * kb, 32 * ng + l31, 32 * ng, scr, F.lane, nullptr); continue; }
            r -= 2 * I_C2;
            { const int kb = r / 4, ng = r % 4;
                transpose_item(F.in[10], 128, 128, (bf16_t*)(F.ws + WS_WKVUP), 64 * kb, 32 * ng + l31, 32 * ng, scr, F.lane, F.in[9]); }
        }
    }
}

template <int MODE>
__device__ __forceinline__ void stage_rows(Frame& F, const float* src, float* dstf, bf16_t* dstu, const float* lng, const float* lnb, const float* sh, const float* sc) {
    const int b = F.blk >> 5;
    f32x4 g4[4], b4[4], sh4[4], sc4[4];
#pragma unroll
    for (int j = 0; j < 4; ++j) { const int c = 4 * F.lane + 256 * j;
        if (MODE != 0) { g4[j] = *(const f32x4*)(lng + c); b4[j] = *(const f32x4*)(lnb + c); }
        if (MODE != 2) { sh4[j] = *(const f32x4*)(sh + (size_t)b * NMOD + c); sc4[j] = *(const f32x4*)(sc + (size_t)b * NMOD + c) + 1.0f; } }
    for (int i = 0; i < 16; ++i) {
        const size_t row = (size_t)F.blk * 128 + F.wave * 16 + i;
        f32x4 v[4];
#pragma unroll
        for (int j = 0; j < 4; ++j) v[j] = *(const f32x4*)(src + row * DM + 4 * F.lane + 256 * j);
        if (MODE != 0) {
            float s = 0.f;
#pragma unroll
            for (int j = 0; j < 4; ++j) s += (v[j][0] + v[j][1]) + (v[j][2] + v[j][3]);
            const float mean = wave_sum(s) * (1.0f / DM); float s2 = 0.f;
#pragma unroll
            for (int j = 0; j < 4; ++j) { v[j] = v[j] - mean; s2 += (v[j][0] * v[j][0] + v[j][1] * v[j][1]) + (v[j][2] * v[j][2] + v[j][3] * v[j][3]); }
            const float rstd = 1.0f / sqrtf(wave_sum(s2) * (1.0f / DM) + LN_EPS);
#pragma unroll
            for (int j = 0; j < 4; ++j) { v[j] = v[j] * rstd * g4[j] + b4[j]; *(f32x4*)(dstf + row * DM + 4 * F.lane + 256 * j) = v[j]; }
        }
        if (MODE != 2) {
#pragma unroll
            for (int j = 0; j < 4; ++j) { const f32x4 u = v[j] * sc4[j] + sh4[j]; u32x2 w; w.x = cvt_pk_bf16(u[0], u[1]); w.y = cvt_pk_bf16(u[2], u[3]);
                *(u32x2*)(dstu + row * DM + 4 * F.lane + 256 * j) = w; }
        }
    }
}
__device__ __forceinline__ void stage_mod_u1(Frame& F) {
    const float* modp = (const float*)(F.ws + WS_MODP); float* mod = (float*)(F.ws + WS_MOD); const float* bada = F.in[3];
    const int b = F.blk >> 5, sl = F.blk & 31;
    LAS float* shsc = (LAS float*)F.lds;
    for (int i = F.tid; i < 2048; i += NTHREADS) { float s = bada[i];
#pragma unroll
        for (int kc = 0; kc < 8; ++kc) s += modp[((size_t)kc * 8 + b) * NMOD + i];
        shsc[i] = s; }
    for (int i = F.tid; i < 288; i += NTHREADS) { const int n = sl * 288 + i; float s = bada[n];
#pragma unroll
        for (int kc = 0; kc < 8; ++kc) s += modp[((size_t)kc * 8 + b) * NMOD + n];
        mod[(size_t)b * NMOD + n] = s; }
    __syncthreads();
    const float* x = F.in[0]; bf16_t* U = (bf16_t*)(F.ws + WS_U);
    f32x4 sh4[4], sc4[4];
#pragma unroll
    for (int j = 0; j < 4; ++j) { const int c = 4 * F.lane + 256 * j; sh4[j] = *(const LAS f32x4*)(shsc + c); sc4[j] = *(const LAS f32x4*)(shsc + 1024 + c) + 1.0f; }
    for (int i = 0; i < 16; ++i) {
        const size_t row = (size_t)F.blk * 128 + F.wave * 16 + i;
#pragma unroll
        for (int j = 0; j < 4; ++j) { const f32x4 v = *(const f32x4*)(x + row * DM + 4 * F.lane + 256 * j); const f32x4 u = v * sc4[j] + sh4[j];
            u32x2 w; w.x = cvt_pk_bf16(u[0], u[1]); w.y = cvt_pk_bf16(u[2], u[3]); *(u32x2*)(U + row * DM + 4 * F.lane + 256 * j) = w; }
    }
    __syncthreads();
}

__device__ __forceinline__ void kvup_item(Frame& F, int it) {
    int lane = F.lane; asm volatile("" : "+v"(lane)); const int l31 = lane & 31, hi = lane >> 5;
    const size_t row = (size_t)it * 32 + l31; const int b = (it * 32) >> 12, t = (int)(row & 4095);
    const bf16_t* kvl = (const bf16_t*)(F.ws + WS_KVL) + row * 128 + hi * 8;
    const bf16_t* W = (const bf16_t*)(F.ws + WS_WKVUP);
    bf16x8 xf[8]; float ss = 0.f;
#pragma unroll
    for (int ks = 0; ks < 8; ++ks) { xf[ks] = *(const bf16x8*)(kvl + ks * 16);
#pragma unroll
        for (int j = 0; j < 8; ++j) { const float v = bf2f((unsigned short)xf[ks][j]); ss += v * v; } }
    ss += __shfl_xor(ss, 32);
    const float rstd = 1.0f / sqrtf(ss * (1.0f / 128.0f) + LN_EPS);
    const f32x2* rope = (const f32x2*)(F.ws + WS_ROPE) + (size_t)t * 32;
    bf16_t* ka = (bf16_t*)(F.ws + WS_KA) + row * 64; bf16_t* vat = (bf16_t*)(F.ws + WS_VAT) + (size_t)b * 64 * SEQ + t;
#pragma unroll
    for (int half = 0; half < 2; ++half) {
        f32x16 acc[2];
#pragma unroll
        for (int q = 0; q < 2; ++q) {
            const int nt = half * 2 + q;
#pragma unroll
            for (int r = 0; r < 16; ++r) acc[q][r] = 0.f;
            const bf16_t* wp = W + (size_t)(nt * 32 + l31) * 128 + hi * 8; asm volatile("" : "+v"(wp));
#pragma unroll
            for (int ks = 0; ks < 8; ++ks) { const bf16x8 wf = *(const bf16x8*)(wp + ks * 16); acc[q] = __builtin_amdgcn_mfma_f32_32x32x16_bf16(wf, xf[ks], acc[q], 0, 0, 0); }
            asm volatile("" ::: "memory");
        }
        if (half == 0) {
#pragma unroll
            for (int k4 = 0; k4 < 4; ++k4) {
                float o1[4], o2[4];
#pragma unroll
                for (int j = 0; j < 4; ++j) { const int r = 4 * k4 + j, d = j + 8 * k4 + 4 * hi; const f32x2 cs = rope[d]; const float a = acc[0][r] * rstd, bb = acc[1][r] * rstd;
                    o1[j] = a * cs[0] - bb * cs[1]; o2[j] = a * cs[1] + bb * cs[0]; }
                u32x2 w1, w2; w1.x = cvt_pk_bf16(o1[0], o1[1]); w1.y = cvt_pk_bf16(o1[2], o1[3]); w2.x = cvt_pk_bf16(o2[0], o2[1]); w2.y = cvt_pk_bf16(o2[2], o2[3]);
                *(u32x2*)(ka + 8 * k4 + 4 * hi) = w1; *(u32x2*)(ka + 32 + 8 * k4 + 4 * hi) = w2;
            }
        } else {
#pragma unroll
            for (int q = 0; q < 2; ++q)
#pragma unroll
                for (int r = 0; r < 16; ++r) { const int d = q * 32 + (r & 3) + 8 * (r >> 2) + 4 * hi; vat[(size_t)d * SEQ] = (unsigned short)(cvt_pk_bf16(acc[q][r] * rstd, 0.f) & 0xffffu); }
        }
        asm volatile("" ::: "memory");
    }
}
__device__ __forceinline__ void cmp2_item(Frame& F, int it) {
    int lane = F.lane; asm volatile("" : "+v"(lane)); const int l31 = lane & 31, hi = lane >> 5; const int kv = it >> 7, rblk = it & 127;
    const size_t row = (size_t)rblk * 32 + l31;
    const bf16_t* hid = (const bf16_t*)(F.ws + (kv ? WS_HIDV : WS_HIDK)) + row * 256 + hi * 8;
    const bf16_t* W = (const bf16_t*)(F.ws + (kv ? WS_WC2V : WS_WC2K));
    f32x16 acc[2];
#pragma unroll
    for (int nt = 0; nt < 2; ++nt)
#pragma unroll
        for (int r = 0; r < 16; ++r) acc[nt][r] = 0.f;
#pragma unroll
    for (int ks = 0; ks < 16; ++ks) { const bf16x8 hf = *(const bf16x8*)(hid + ks * 16);
#pragma unroll
        for (int nt = 0; nt < 2; ++nt) { const bf16x8 wf = *(const bf16x8*)(W + (size_t)(nt * 32 + l31) * 256 + ks * 16 + hi * 8); acc[nt] = __builtin_amdgcn_mfma_f32_32x32x16_bf16(wf, hf, acc[nt], 0, 0, 0); } }
    if (kv == 0) {
        bf16_t* o = (bf16_t*)(F.dout + DO_KCMP) + row * 64;
#pragma unroll
        for (int nt = 0; nt < 2; ++nt)
#pragma unroll
            for (int k4 = 0; k4 < 4; ++k4) { u32x2 w; w.x = cvt_pk_bf16(acc[nt][4 * k4], acc[nt][4 * k4 + 1]); w.y = cvt_pk_bf16(acc[nt][4 * k4 + 2], acc[nt][4 * k4 + 3]); *(u32x2*)(o + nt * 32 + 8 * k4 + 4 * hi) = w; }
    } else {
        const int bg = (int)(row >> 8), c = (int)(row & 255);
        bf16_t* o = (bf16_t*)(F.dout + DO_VCMPT) + (size_t)bg * 64 * 256 + c;
#pragma unroll
        for (int nt = 0; nt < 2; ++nt)
#pragma unroll
            for (int r = 0; r < 16; ++r) { const int d = nt * 32 + (r & 3) + 8 * (r >> 2) + 4 * hi; o[(size_t)d * 256] = (unsigned short)(cvt_pk_bf16(acc[nt][r], 0.f) & 0xffffu); }
    }
}

constexpr int SEL_ROW = 4100;
__device__ __forceinline__ unsigned ord_key(float v) { unsigned u = __float_as_uint(v); if (u == 0x80000000u) u = 0u; return (u & 0x80000000u) ? ~u : (u | 0x80000000u); }
__device__ __forceinline__ void hist_zero(LAS unsigned* hist, int lane) {
#pragma unroll
    for (int i = 0; i < 8; ++i) *(LAS u32x4*)(hist + 32 * lane + 4 * i) = (u32x4){0u, 0u, 0u, 0u};
    LDS_WAIT(); asm volatile("" ::: "memory");
}
__device__ __forceinline__ void hist_add(LAS unsigned* hist, unsigned d) { __hip_atomic_fetch_add(hist + d, 1u, __ATOMIC_RELAXED, __HIP_MEMORY_SCOPE_WORKGROUP); }
__device__ __forceinline__ unsigned hist_find(LAS unsigned* hist, int lane, unsigned& need) {
    LDS_WAIT(); asm volatile("" ::: "memory");
    unsigned hv[32]; unsigned lsum = 0u;
#pragma unroll
    for (int i = 0; i < 8; ++i) { const u32x4 q4 = *(const LAS u32x4*)(hist + 32 * lane + 4 * i); hv[4 * i] = q4.x; hv[4 * i + 1] = q4.y; hv[4 * i + 2] = q4.z; hv[4 * i + 3] = q4.w; lsum += (q4.x + q4.y) + (q4.z + q4.w); }
    LDS_WAIT(); asm volatile("" ::: "memory");
    unsigned suf = lsum;
#pragma unroll
    for (int o = 1; o < 64; o <<= 1) { const unsigned y = (unsigned)__shfl_down((int)suf, o); if (lane + o < 64) suf += y; }
    const unsigned above_lane = suf - lsum;
    const bool mine = (above_lane < need) && (suf >= need);
    unsigned running = above_lane, dstar = 0u, above = 0u; bool found = false;
#pragma unroll
    for (int d = 31; d >= 0; --d) { const unsigned c = running + hv[d]; const bool hit = !found && (c >= need); dstar = hit ? (unsigned)d : dstar; above = hit ? running : above; found = found || hit; running = c; }
    const unsigned long long bal = __ballot(mine);
    const int src = bal ? (int)__builtin_ctzll(bal) : 0;
    const unsigned dsel = (unsigned)__shfl((int)(32u * (unsigned)lane + dstar), src);
    const unsigned ab = (unsigned)__shfl((int)above, src);
    need -= ab;
    return dsel;
}
__device__ __forceinline__ void dsa_select_unit(Frame& F, int b, int tq) {
    const int lane = F.lane, l31 = lane & 31, hi = lane >> 5, wave = F.wave;
    const int t0 = tq * 8;
    LAS float* S = (LAS float*)F.lds;
    {
        const int q = l31 >> 2, h = l31 & 3;
        const _Float16* QI = (const _Float16*)(F.ws + WS_QI) + ((size_t)b * SEQ + t0 + q) * 256 + h * 64 + hi * 8;
        const _Float16* KI = (const _Float16*)(F.ws + WS_KI) + (size_t)b * SEQ * 64;
        const float w = ((const float*)(F.dout + DO_WI))[((size_t)b * SEQ + t0 + q) * 4 + h];
        f16x8 qf[4];
#pragma unroll
        for (int ks = 0; ks < 4; ++ks) qf[ks] = *(const f16x8*)(QI + ks * 16);
        const int ntile = (t0 >> 5) + 1;
        for (int tile = wave; tile < ntile; tile += NWAVES) {
            const _Float16* kp = KI + (size_t)(tile * 32 + l31) * 64 + hi * 8;
            f32x16 s;
#pragma unroll
            for (int r = 0; r < 16; ++r) s[r] = 0.f;
#pragma unroll
            for (int ks = 0; ks < 4; ++ks) { const f16x8 kf = *(const f16x8*)(kp + ks * 16); s = __builtin_amdgcn_mfma_f32_32x32x16_f16(kf, qf[ks], s, 0, 0, 0); }
#pragma unroll
            for (int r = 0; r < 16; ++r) { float v = fmaxf(s[r], 0.f) * w; v += __shfl_xor(v, 1); v += __shfl_xor(v, 2);
                if ((r & 3) == h) S[q * SEL_ROW + tile * 32 + (r & 3) + 8 * (r >> 2) + 4 * hi] = v; }
        }
    }
    __syncthreads();
#define SEL_PASS(COND, DIGIT) do { int ln_ = lane; asm volatile("" : "+v"(ln_)); const unsigned Lb_ = 4095u - (unsigned)ln_; hist_zero(hist, ln_); \
        _Pragma("unroll") for (int i = 0; i < 64; ++i) { const unsigned o = ord[i]; const unsigned L = Lb_ - 64u * (unsigned)i; (void)L; if (COND) hist_add(hist, (DIGIT)); } } while (0)
    {
        const int t = t0 + wave, n = t + 1;
        LAS float* row = S + wave * SEL_ROW;
        unsigned ord[64];
        { int ln_ = lane; asm volatile("" : "+v"(ln_)); const LAS float* rp = row + ln_;
#pragma unroll
          for (int i = 0; i < 64; ++i) { float v = 0.f; if (64 * i < n) v = rp[64 * i]; ord[i] = (64 * i + ln_ < n) ? ord_key(v) : 0u; } }
        LDS_WAIT(); asm volatile("" ::: "memory");
        unsigned Hs = 1u, Ls = 0u;
        if (n > 256) {
            LAS unsigned* hist = (LAS unsigned*)row;
            unsigned need = 256u;
            SEL_PASS(true, o >> 21);
            const unsigned d0 = hist_find(hist, lane, need);
            SEL_PASS((o >> 21) == d0, (o >> 10) & 2047u);
            const unsigned d1 = hist_find(hist, lane, need);
            const unsigned P2 = (d0 << 11) | d1;
            SEL_PASS((o >> 10) == P2, ((o & 1023u) << 1) | (L >> 11));
            const unsigned d2 = hist_find(hist, lane, need);
            Hs = (P2 << 10) | (d2 >> 1); const unsigned lb = d2 & 1u;
            SEL_PASS(o == Hs && (L >> 11) == lb, L & 2047u);
            const unsigned d3 = hist_find(hist, lane, need);
            Ls = (lb << 11) | d3;
        }
        unsigned mlo = 0u, mhi = 0u;
        { int ln_ = lane; asm volatile("" : "+v"(ln_)); const unsigned Lb_ = 4095u - (unsigned)ln_;
#pragma unroll
          for (int i = 0; i < 64; ++i) { const unsigned L = Lb_ - 64u * (unsigned)i;
            const bool sel = (ord[i] > Hs || (ord[i] == Hs && L >= Ls));
            const unsigned long long bal = __ballot(sel);
            const unsigned blo = (unsigned)bal, bhi = (unsigned)(bal >> 32);
            asm("s_nop 3\n\tv_writelane_b32 %0, %2, %4\n\tv_writelane_b32 %1, %3, %4" : "+v"(mlo), "+v"(mhi) : "s"(blo), "s"(bhi), "n"(i)); } }
        u32x2* mrow = (u32x2*)(F.ws + WS_MASK) + ((size_t)b * SEQ + t) * 64;
        mrow[lane] = (u32x2){mlo, mhi};
    }
#undef SEL_PASS
    __syncthreads();
}

__device__ __forceinline__ void dsa_attn_unit(Frame& F, int b, int qt) {
    const int lane = F.lane, l31 = lane & 31, hi = lane >> 5, h = F.wave;
    const int t = qt * 32 + l31;
    bf16_t* qrow = (bf16_t*)(F.ws + WS_QA) + ((size_t)b * SEQ + t) * 512 + h * 64;
    bf16x8 qf[4];
#pragma unroll
    for (int ks = 0; ks < 4; ++ks) qf[ks] = *(const bf16x8*)(qrow + ks * 16 + hi * 8);
    const bf16_t* K = (const bf16_t*)(F.ws + WS_KA) + (size_t)b * SEQ * 64 + (size_t)l31 * 64 + hi * 8;
    const bf16_t* VT = (const bf16_t*)(F.ws + WS_VAT) + (size_t)b * 64 * SEQ + (size_t)l31 * SEQ + 4 * hi;
    const unsigned* mrow = (const unsigned*)(F.ws + WS_MASK) + ((size_t)b * SEQ + t) * 128;
    AttnAcc A; attn_init(A);
    for (int tile = 0; tile <= qt; ++tile) {
        const unsigned vm = mrow[tile];
        attn_step(A, qf, K + (size_t)tile * 32 * 64, VT + tile * 32, SEQ, vm, hi);
    }
    const float il = attn_inv_l(A);
#pragma unroll
    for (int r = 0; r < 16; ++r) { A.o0[r] *= il; A.o1[r] *= il; }
    attn_store(A.o0, A.o1, qrow, hi);
}

constexpr int IMP_Q = 65;
__device__ __forceinline__ void nsa_unit(Frame& F, int b, int g, int qt64) {
    const int lane = F.lane, l31 = lane & 31, hi = lane >> 5, sub = F.wave >> 2, rr = F.wave & 3, head = g * 4 + rr;
    const int tsub = qt64 * 64 + sub * 32, t = tsub + l31;
    LAS float* IMP = (LAS float*)F.lds;
    LAS unsigned long long* SELM = (LAS unsigned long long*)(F.lds + 2 * 4 * 32 * IMP_Q * 4);
    bf16_t* qrow = (bf16_t*)(F.dout + DO_QB) + ((size_t)b * SEQ + t) * 512 + head * 64;
    bf16x8 qf[4];
#pragma unroll
    for (int ks = 0; ks < 4; ++ks) qf[ks] = *(const bf16x8*)(qrow + ks * 16 + hi * 8);
    const float* gb = (const float*)(F.dout + DO_GB) + ((size_t)b * SEQ + t) * 24;
    const float g_c = gb[head], g_s = gb[8 + head], g_w = gb[16 + head];
    const int bg = b * 2 + g;
    f32x16 out0, out1;
    {
        const bf16_t* K = (const bf16_t*)(F.dout + DO_KCMP) + (size_t)bg * 256 * 64 + (size_t)l31 * 64 + hi * 8;
        const bf16_t* VT = (const bf16_t*)(F.dout + DO_VCMPT) + (size_t)bg * 64 * 256 + (size_t)l31 * 256 + 4 * hi;
        const int cl = (t - 31) >> 4;
        const int clw = tsub >> 4;
        const int ntile = (clw >> 5) + 1;
        float m = -1e30f, l = 0.f;
        for (int tile = 0; tile < ntile; ++tile) {
            f32x16 s;
#pragma unroll
            for (int r = 0; r < 16; ++r) s[r] = 0.f;
            const bf16_t* kp = K + (size_t)tile * 32 * 64;
#pragma unroll
            for (int ks = 0; ks < 4; ++ks) { const bf16x8 kf = *(const bf16x8*)(kp + ks * 16); s = __builtin_amdgcn_mfma_f32_32x32x16_bf16(kf, qf[ks], s, 0, 0, 0); }
            float mx = -INFINITY;
#pragma unroll
            for (int r = 0; r < 16; ++r) { const int c = tile * 32 + (r & 3) + 8 * (r >> 2) + 4 * hi; if (c > cl) s[r] = -INFINITY; mx = fmaxf(mx, s[r]); }
            const float mn = fmaxf(m, mx); float ls = 0.f;
#pragma unroll
            for (int r = 0; r < 16; ++r) ls += __builtin_amdgcn_exp2f(s[r] - mn);
            l = l * __builtin_amdgcn_exp2f(m - mn) + ls; m = mn;
        }
        { const float mo = __shfl_xor(m, 32), lo = __shfl_xor(l, 32); const float mn = fmaxf(m, mo);
          l = l * __builtin_amdgcn_exp2f(m - mn) + lo * __builtin_amdgcn_exp2f(mo - mn); m = mn; }
        const float il = l > 0.f ? 1.0f / l : 0.f;
        f32x16 o0, o1;
#pragma unroll
        for (int r = 0; r < 16; ++r) { o0[r] = 0.f; o1[r] = 0.f; }
        float carry = 0.f;
        LAS float* imp = IMP + ((sub * 4 + rr) * 32 + l31) * IMP_Q;
#pragma unroll 1
        for (int tile = 0; tile < 8; ++tile) {
            f32x16 s;
#pragma unroll
            for (int r = 0; r < 16; ++r) s[r] = 0.f;
            if (tile < ntile) {
                const bf16_t* kp = K + (size_t)tile * 32 * 64;
#pragma unroll
                for (int ks = 0; ks < 4; ++ks) { const bf16x8 kf = *(const bf16x8*)(kp + ks * 16); s = __builtin_amdgcn_mfma_f32_32x32x16_bf16(kf, qf[ks], s, 0, 0, 0); }
#pragma unroll
                for (int r = 0; r < 16; ++r) { const int c = tile * 32 + (r & 3) + 8 * (r >> 2) + 4 * hi; s[r] = (c > cl) ? 0.f : __builtin_amdgcn_exp2f(s[r] - m) * il; }
                u32x4 p0, p1;
                p0.x = cvt_pk_bf16(s[0], s[1]); p0.y = cvt_pk_bf16(s[2], s[3]); p0.z = cvt_pk_bf16(s[4], s[5]); p0.w = cvt_pk_bf16(s[6], s[7]);
                p1.x = cvt_pk_bf16(s[8], s[9]); p1.y = cvt_pk_bf16(s[10], s[11]); p1.z = cvt_pk_bf16(s[12], s[13]); p1.w = cvt_pk_bf16(s[14], s[15]);
                const bf16x8 pb0 = __builtin_bit_cast(bf16x8, p0), pb1 = __builtin_bit_cast(bf16x8, p1);
                const bf16_t* vp = VT + tile * 32;
#pragma unroll
                for (int dt = 0; dt < 2; ++dt)
#pragma unroll
                    for (int st = 0; st < 2; ++st) { const s16x4 a = *(const s16x4*)(vp + (size_t)dt * 32 * 256 + st * 16), c2 = *(const s16x4*)(vp + (size_t)dt * 32 * 256 + st * 16 + 8);
                        const bf16x8 vf = (bf16x8){a[0], a[1], a[2], a[3], c2[0], c2[1], c2[2], c2[3]};
                        if (dt == 0) o0 = __builtin_amdgcn_mfma_f32_32x32x16_bf16(vf, st ? pb1 : pb0, o0, 0, 0, 0); else o1 = __builtin_amdgcn_mfma_f32_32x32x16_bf16(vf, st ? pb1 : pb0, o1, 0, 0, 0); }
            }
            float rec[4], sum4[4];
#pragma unroll
            for (int k = 0; k < 4; ++k) { sum4[k] = (s[4 * k] + s[4 * k + 1]) + (s[4 * k + 2] + s[4 * k + 3]); rec[k] = __shfl_xor(s[4 * k + 3], 32); }
#pragma unroll
            for (int k = 0; k < 4; ++k) { const float add = hi ? rec[k] : (k == 0 ? carry : rec[k - 1]); imp[8 * tile + 2 * k + hi] = sum4[k] + add; }
            carry = rec[3];
        }
#pragma unroll
        for (int r = 0; r < 16; ++r) { out0[r] = g_c * o0[r]; out1[r] = g_c * o1[r]; }
    }
    __syncthreads();
    if (F.wave == 0) {
        const int qs = lane >> 5, ql = lane & 31; const int tq = qt64 * 64 + lane, blkq = tq >> 6;
        LAS float* v0 = IMP + ((qs * 4 + 0) * 32 + ql) * IMP_Q; LAS float* v1 = v0 + 32 * IMP_Q; LAS float* v2 = v1 + 32 * IMP_Q; LAS float* v3 = v2 + 32 * IMP_Q;
        unsigned long long msk = 0ull;
        if (blkq < 16) { msk = (blkq == 63) ? ~0ull : ((1ull << (blkq + 1)) - 1ull); }
        else {
            for (int j = 0; j <= blkq; ++j) { float v = ((v0[j] + v1[j]) + v2[j]) + v3[j]; if (j == 0 || j == blkq || j == blkq - 1) v += 1e4f; v0[j] = v; }
            for (int it = 0; it < 16; ++it) { float best = -INFINITY; int bj = 0;
                for (int j = 0; j <= blkq; ++j) { const float v = v0[j]; if (v > best) { best = v; bj = j; } }
                msk |= 1ull << bj; v0[bj] = -INFINITY; }
        }
        SELM[lane] = msk;
    }
    __syncthreads();
    {
        const unsigned long long selm = SELM[sub * 32 + l31];
        const bf16_t* K = (const bf16_t*)(F.ws + WS_KS) + (size_t)bg * SEQ * 64 + (size_t)l31 * 64 + hi * 8;
        const bf16_t* VT = (const bf16_t*)(F.ws + WS_VST) + (size_t)bg * 64 * SEQ + (size_t)l31 * SEQ + 4 * hi;
        AttnAcc A; attn_init(A);
        const int jmax = (tsub + 31) >> 6;
        for (int j = 0; j <= jmax; ++j) {
            const bool mine = (selm >> j) & 1ull;
            if (__ballot(mine) == 0ull) continue;
#pragma unroll 1
            for (int hh = 0; hh < 2; ++hh) {
                const int key0 = j * 64 + hh * 32;
                if (key0 > tsub + 31) break;
                unsigned vm = 0u;
                if (mine) { const int d = t - key0; vm = d >= 31 ? 0xffffffffu : (d < 0 ? 0u : ((2u << d) - 1u)); }
                attn_step(A, qf, K + (size_t)key0 * 64, VT + key0, SEQ, vm, hi);
            }
        }
        const float il = attn_inv_l(A) * g_s;
#pragma unroll
        for (int r = 0; r < 16; ++r) { out0[r] += il * A.o0[r]; out1[r] += il * A.o1[r]; }
    }
    {
        const bf16_t* K = (const bf16_t*)(F.ws + WS_KW) + (size_t)bg * SEQ * 64 + (size_t)l31 * 64 + hi * 8;
        const bf16_t* VT = (const bf16_t*)(F.ws + WS_VWT) + (size_t)bg * 64 * SEQ + (size_t)l31 * SEQ + 4 * hi;
        AttnAcc A; attn_init(A);
        const int tile_hi = tsub >> 5; int tile_lo = tile_hi - 16; if (tile_lo < 0) tile_lo = 0;
        for (int tile = tile_lo; tile <= tile_hi; ++tile) {
            const int key0 = tile * 32;
            const int dhi = t - key0, dlo = t - 511 - key0;
            unsigned vm = dhi >= 31 ? 0xffffffffu : (dhi < 0 ? 0u : ((2u << dhi) - 1u));
            if (dlo > 0) vm &= (dlo >= 32 ? 0u : ~((1u << dlo) - 1u));
            attn_step(A, qf, K + (size_t)key0 * 64, VT + key0, SEQ, vm, hi);
        }
        const float il = attn_inv_l(A) * g_w;
#pragma unroll
        for (int r = 0; r < 16; ++r) { out0[r] += il * A.o0[r]; out1[r] += il * A.o1[r]; }
    }
    attn_store(out0, out1, qrow, hi);
    __syncthreads();
}


#ifndef DBG_PROBE
#define DBG_PROBE 0
#endif

__device__ __forceinline__ void naive_ffn1_row(Frame& F, const float* out) {
    LAS float* u = (LAS float*)F.lds; LAS float* h = u + 1024;
    LAS float* red = h + 2816;
    const int row = F.blk * 128 + 77;
    const float* x = (DBG_PROBE == 9 ? (const float*)(F.ws + WS_XR) : F.in[0]) + (size_t)row * DM; const float* mod = (const float*)(F.ws + WS_MOD) + (size_t)(row >> 12) * NMOD + (DBG_PROBE == 9 ? 6 * DM : 0);
    for (int k = F.tid; k < DM; k += NTHREADS) u[k] = x[k] * (1.0f + mod[DM + k]) + mod[k];
    __syncthreads();
    const float* win = F.in[DBG_PROBE == 9 ? 22 : 4]; const float* wout = F.in[DBG_PROBE == 9 ? 23 : 5];
    for (int j = F.tid; j < DFF; j += NTHREADS) { float a = 0.f, b = 0.f;
        for (int k = 0; k < DM; ++k) { a += u[k] * win[(size_t)k * NFF + j]; b += u[k] * win[(size_t)k * NFF + DFF + j]; }
        h[j] = (a / (1.0f + __expf(-a))) * b; }
    __syncthreads();
    float sd = 0.f, sr = 0.f;
    for (int n = F.tid; n < DM; n += NTHREADS) { float f = 0.f;
        for (int k = 0; k < DFF; ++k) f += h[k] * wout[(size_t)k * DM + n];
        const float term = 0.5f * mod[2 * DM + n] * f; const float fast = out[(size_t)row * DM + n] - ALPHA * x[n];
        sd += fabsf(fast - term); sr += fabsf(term); }
    sd = wave_sum(sd); sr = wave_sum(sr);
    if (F.lane == 0) { red[F.wave] = sd; red[8 + F.wave] = sr; }
    __syncthreads();
    if (F.tid == 0) { float a = 0.f, b = 0.f; for (int w = 0; w < 8; ++w) { a += red[w]; b += red[8 + w]; }
        float* slot = (float*)(F.ws + WS_CTL + 32768); slot[2 * F.blk] = a; slot[2 * F.blk + 1] = b; }
}
__device__ __forceinline__ void probe_stage(Frame& F, float* out, const XcdBarrier& bar) {
    if (DBG_PROBE == 8 || DBG_PROBE == 9) { naive_ffn1_row(F, out); xcd_barrier(bar); }
    if (DBG_PROBE == 11) {
        LAS float* red = (LAS float*)F.lds; float sd = 0.f, sr = 0.f;
        const int row = F.blk * 128 + 77; const float* y = out + (size_t)row * DM; const float* mod = (const float*)(F.ws + WS_MOD) + (size_t)(row >> 12) * NMOD;
        float mean = 0.f; for (int k = 0; k < DM; ++k) mean += y[k]; mean /= DM;
        float var = 0.f; for (int k = 0; k < DM; ++k) { const float d = y[k] - mean; var += d * d; } var /= DM;
        const float rstd = 1.0f / sqrtf(var + LN_EPS);
        for (int n = F.tid; n < DM; n += NTHREADS) { const float xn = (y[n] - mean) * rstd * F.in[6][n] + F.in[7][n];
            const float un = xn * (1.0f + mod[4 * DM + n]) + mod[3 * DM + n];
            sd += fabsf(xn - ((const float*)(F.ws + WS_XR))[(size_t)row * DM + n]) + fabsf(un - bf2f(((const bf16_t*)(F.ws + WS_U))[(size_t)row * DM + n])); sr += fabsf(xn) + fabsf(un); }
        sd = wave_sum(sd); sr = wave_sum(sr);
        if (F.lane == 0) { red[F.wave] = sd; red[8 + F.wave] = sr; }
        __syncthreads();
        if (F.tid == 0) { float a = 0.f, b2 = 0.f; for (int w = 0; w < 8; ++w) { a += red[w]; b2 += red[8 + w]; }
            float* slot = (float*)(F.ws + WS_CTL + 32768); slot[2 * F.blk] = a; slot[2 * F.blk + 1] = b2; }
        xcd_barrier(bar);
    }
    if (DBG_PROBE == 10) {
        LAS float* red = (LAS float*)F.lds; float sd = 0.f, sr = 0.f;
        if (F.tid < 288) { const int b = F.tid / 36, n = 36 * F.blk + F.tid % 36; float acc = F.in[3][n];
            for (int k = 0; k < DM; ++k) { const float c = F.in[1][b * DM + k]; acc += (c / (1.0f + __expf(-c))) * F.in[2][(size_t)k * NMOD + n]; }
            const float m = ((const float*)(F.ws + WS_MOD))[(size_t)b * NMOD + n]; sd = fabsf(m - acc); sr = fabsf(acc); }
        sd = wave_sum(sd); sr = wave_sum(sr);
        if (F.lane == 0) { red[F.wave] = sd; red[8 + F.wave] = sr; }
        __syncthreads();
        if (F.tid == 0) { float a = 0.f, b2 = 0.f; for (int w = 0; w < 8; ++w) { a += red[w]; b2 += red[8 + w]; }
            float* slot = (float*)(F.ws + WS_CTL + 32768); slot[2 * F.blk] = a; slot[2 * F.blk + 1] = b2; }
        xcd_barrier(bar);
    }
    float val = 0.f;
    if (F.blk == 0) {
        float acc = 0.f; const int N = 1 << 18;
        for (int i = F.tid; i < N; i += NTHREADS) {
            float v = 0.f;
            if (DBG_PROBE == 1) v = ((const float*)(F.ws + WS_MOD))[i % (8 * NMOD)];
            if (DBG_PROBE == 2) v = bf2f(((const bf16_t*)(F.ws + WS_W1IN))[i]);
            if (DBG_PROBE == 3) v = bf2f(((const bf16_t*)(F.ws + WS_HF))[i]);
            if (DBG_PROBE == 4) v = bf2f(((const bf16_t*)(F.ws + WS_U))[i]);
            if (DBG_PROBE == 5) v = ((const float*)(F.ws + WS_XR))[i];
            if (DBG_PROBE == 6) v = bf2f(((const bf16_t*)(F.ws + WS_W1OUT))[i]);
            if (DBG_PROBE == 7) v = out[i] - ALPHA * F.in[0][i];
            acc += fabsf(v);
        }
        acc = wave_sum(acc);
        LAS float* red = (LAS float*)F.lds;
        if (F.lane == 0) red[F.wave] = acc;
        __syncthreads();
        float s = 0.f; for (int w = 0; w < NWAVES; ++w) s += red[w];
        val = 1000.0f * s / (float)N;
        if (DBG_PROBE >= 8) { const float* slot = (const float*)(F.ws + WS_CTL + 32768); float a = 0.f, b = 0.f; for (int i = 0; i < 256; ++i) { a += slot[2 * i]; b += slot[2 * i + 1]; } val = 100000.0f * a / b; }
    }
    xcd_barrier(bar);
    for (size_t i = (size_t)F.blk * NTHREADS + F.tid; i < (size_t)MROWS * DM / 4; i += (size_t)F.G * NTHREADS) ((f32x4*)out)[i] = (f32x4){i == 0 ? val : 0.f, 0.f, 0.f, 0.f};
}

__global__ void __launch_bounds__(NTHREADS, 2) mk_fwd(Args args) {
    extern __shared__ __attribute__((aligned(16))) unsigned char lds_raw[];
    cg::grid_group grid = cg::this_grid();
    Frame F;
    F.lds = (LAS unsigned char*)lds_raw; F.in = args.in;
    LAS int* qword = (LAS int*)(F.lds + LDS_BYTES - 16);
    volatile LAS unsigned* bst = (volatile LAS unsigned*)(F.lds + LDS_BYTES - 32);
    if (threadIdx.x < 8) ((LAS unsigned*)(F.lds + LDS_BYTES - 32))[threadIdx.x] = 0u;
    __syncthreads();
    XcdBarrier bar = xcd_barrier_post((unsigned*)(args.ws + WS_CTL) + CW_BAR, bst);

    const int lo = args.ph_lo, hi = args.ph_hi;
    unsigned char* ws_ = args.ws; float* out_ = args.out; int tid_ = threadIdx.x;
#define RELAUNDER() do { ws_ = launder_ptr(ws_); out_ = launder_ptr(out_); asm volatile("" : "+v"(tid_)); \
        { int b_ = blockIdx.x, g_ = gridDim.x; asm volatile("" : "+v"(b_), "+v"(g_)); F.blk = __builtin_amdgcn_readfirstlane(b_); F.G = __builtin_amdgcn_readfirstlane(g_); } \
        F.ws = ws_; F.dout = (unsigned char*)out_; F.tid = tid_; F.lane = tid_ & 63; F.wave = __builtin_amdgcn_readfirstlane(tid_ >> 6); } while (0)
#define IN(k) (lo <= (k) && (k) < hi && STG(k))
#define SYNC(k) do { if (lo <= (k) && (k) + 1 < hi) { if ((k) == 0) grid.sync(); else xcd_barrier(bar); } } while (0)
#define MODP ((const float*)(F.ws + WS_MOD))
#define UBUF ((bf16_t*)(F.ws + WS_U))
#define XRBUF ((float*)(F.ws + WS_XR))
#define HFBUF ((bf16_t*)(F.ws + WS_HF))
#define GW (F.blk * NWAVES + F.wave)
#define NGW (F.G * NWAVES)
    if (IN(0)) { RELAUNDER(); stage_prologue(F, args); }
    SYNC(0);
    if (IN(1)) { RELAUNDER(); stage_mod_u1(F); }
    SYNC(1);
    if (IN(2)) { RELAUNDER();
        pg8::Gemm g{UBUF, (const bf16_t*)(F.ws + WS_W1IN), MROWS, NFF, DM, DM}; pg8::StaticOrder S; S.init(MROWS, NFF, F.G, F.blk);
        EpiSwiglu E{HFBUF}; pg8::gemm_phase(F.lds, g, S, E); }
    SYNC(2);
    if (IN(3)) { RELAUNDER();
        pg8::Gemm g{HFBUF, (const bf16_t*)(F.ws + WS_W1OUT), MROWS, DM, DFF, DFF}; pg8::StaticOrder S; S.init(MROWS, DM, F.G, F.blk);
        EpiResid E{F.in[0], MODP + 2 * DM, out_, FFN1_COEF}; pg8::gemm_phase(F.lds, g, S, E); }
    SYNC(3);
    if (IN(4)) { RELAUNDER(); stage_rows<1>(F, out_, XRBUF, UBUF, F.in[6], F.in[7], MODP + 3 * DM, MODP + 4 * DM); }
    SYNC(4);
#if !DBG_SKIP_MIXER
    if (IN(5)) { RELAUNDER();
        pg8::Gemm g{UBUF, (const bf16_t*)(F.ws + WS_WMIX), MROWS, NMIX, DM, DM}; pg8::StaticOrder S; S.init(MROWS, NMIX, F.G, F.blk);
        EpiMix E{F.ws, F.dout}; pg8::gemm_phase(F.lds, g, S, E); }
    SYNC(5);
    if (IN(6)) {
        RELAUNDER();
        { const int kv = F.blk >> 4;
          pg8::Gemm g{(const bf16_t*)(F.ws + (kv ? WS_VC : WS_KC)), (const bf16_t*)(F.ws + (kv ? WS_WC1V : WS_WC1K)), 4096, 256, 2048, 1024};
          pg8::StaticOrder S; S.init(4096, 256, F.G, F.blk < 32 ? (F.blk & 15) : -1);
          EpiCmp1 E{F.ws, kv}; pg8::gemm_phase(F.lds, g, S, E); }
        RELAUNDER();
        for (int it = GW; it < MROWS / 32; it += NGW) kvup_item(F, it);
        __syncthreads();
        RELAUNDER();
        for (;;) { if (F.tid == 0) *qword = (int)atomicAdd((unsigned*)(F.ws + WS_CTL) + CW_QSEL, 1u); __syncthreads(); const int u = *qword; __syncthreads(); if (u >= NB * 512) break;
            dsa_select_unit(F, u & 7, 511 - (u >> 3)); }
    }
    SYNC(6);
    if (IN(7)) {
        RELAUNDER();
        for (int it = GW; it < 256; it += NGW) cmp2_item(F, it);
        RELAUNDER();
        for (;;) { if (F.tid == 0) *qword = (int)atomicAdd((unsigned*)(F.ws + WS_CTL) + CW_QDSA, 1u); __syncthreads(); const int u = *qword; __syncthreads(); if (u >= NB * 128) break;
            dsa_attn_unit(F, u & 7, 127 - (u >> 3)); }
    }
    SYNC(7);
    if (IN(8)) {
        RELAUNDER();
        for (;;) { if (F.tid == 0) *qword = (int)atomicAdd((unsigned*)(F.ws + WS_CTL) + CW_QNSA, 1u); __syncthreads(); const int u = *qword; __syncthreads(); if (u >= NB * 2 * 64) break;
            nsa_unit(F, (u & 15) >> 1, u & 1, 63 - (u >> 4)); }
    }
    SYNC(8);
    if (IN(9)) { RELAUNDER();
        pg8::Gemm g{(const bf16_t*)(F.ws + WS_QA), (const bf16_t*)(F.ws + WS_WBRA), MROWS, DM, 512, 512}; pg8::StaticOrder S; S.init(MROWS, DM, F.G, F.blk);
        EpiGate E{(const bf16_t*)(F.ws + WS_GATE), 0, nullptr, (bf16_t*)(F.dout + DO_T)}; pg8::gemm_phase(F.lds, g, S, E); }
    SYNC(9);
    if (IN(10)) { RELAUNDER();
        pg8::Gemm g{(const bf16_t*)(F.dout + DO_QB), (const bf16_t*)(F.ws + WS_WBRB), MROWS, DM, 512, 512}; pg8::StaticOrder S; S.init(MROWS, DM, F.G, F.blk);
        EpiGate E{(const bf16_t*)(F.ws + WS_GATE), 1024, (const bf16_t*)(F.dout + DO_T), UBUF}; pg8::gemm_phase(F.lds, g, S, E); }
    SYNC(10);
    if (IN(11)) { RELAUNDER();
        pg8::Gemm g{UBUF, (const bf16_t*)(F.ws + WS_WMO), MROWS, DM, DM, DM}; pg8::StaticOrder S; S.init(MROWS, DM, F.G, F.blk);
        EpiResid E{XRBUF, MODP + 5 * DM, out_, 1.0f}; pg8::gemm_phase(F.lds, g, S, E); }
    SYNC(11);
#else
    SYNC(5); SYNC(6); SYNC(7); SYNC(8); SYNC(9); SYNC(10);
    if (IN(11)) { RELAUNDER();
        for (size_t i = (size_t)F.blk * NTHREADS + F.tid; i < (size_t)MROWS * DM / 4; i += (size_t)F.G * NTHREADS) ((f32x4*)out_)[i] = ((const f32x4*)XRBUF)[i] * ALPHA; }
    SYNC(11);
#endif
    if (IN(12)) { RELAUNDER(); stage_rows<1>(F, out_, XRBUF, UBUF, F.in[20], F.in[21], MODP + 6 * DM, MODP + 7 * DM); }
    SYNC(12);
    if (IN(13)) { RELAUNDER();
        pg8::Gemm g{UBUF, (const bf16_t*)(F.ws + WS_W2IN), MROWS, NFF, DM, DM}; pg8::StaticOrder S; S.init(MROWS, NFF, F.G, F.blk);
        EpiSwiglu E{HFBUF}; pg8::gemm_phase(F.lds, g, S, E); }
    SYNC(13);
    if (IN(14)) { RELAUNDER();
        pg8::Gemm g{HFBUF, (const bf16_t*)(F.ws + WS_W2OUT), MROWS, DM, DFF, DFF}; pg8::StaticOrder S; S.init(MROWS, DM, F.G, F.blk);
        EpiResid E{XRBUF, MODP + 8 * DM, out_, FFN2_COEF}; pg8::gemm_phase(F.lds, g, S, E); }
    SYNC(14);
    if (IN(15)) { RELAUNDER(); stage_rows<2>(F, out_, out_, nullptr, F.in[24], F.in[25], nullptr, nullptr); }
    if (DBG_PROBE) { xcd_barrier(bar); RELAUNDER(); probe_stage(F, out_, bar); }
}

extern "C" void kernel_launch(void* const* d_in, const int* in_sizes, int n_in, void* d_out, int out_size, void* d_ws, size_t ws_size, hipStream_t stream) {
    static int grid = 0;
    if (grid == 0) {
        if (n_in != 26 || out_size != MROWS * DM || ws_size < WS_END) { fprintf(stderr, "kernel_launch: unexpected shapes (n_in %d out %d ws %zu)\n", n_in, out_size, ws_size); grid = -1; return; }
        if (hipFuncSetAttribute((const void*)mk_fwd, hipFuncAttributeMaxDynamicSharedMemorySize, LDS_BYTES) != hipSuccess) { fprintf(stderr, "kernel_launch: hipFuncSetAttribute failed\n"); grid = -1; return; }
        int dev = 0, cus = 0, per_cu = 0;
        hipGetDevice(&dev); hipDeviceGetAttribute(&cus, hipDeviceAttributeMultiprocessorCount, dev);
        hipOccupancyMaxActiveBlocksPerMultiprocessor(&per_cu, (const void*)mk_fwd, NTHREADS, LDS_BYTES);
        (void)hipGetLastError();
        if (per_cu < 1 || cus != 256) fprintf(stderr, "kernel_launch: note: occupancy %d blocks/CU, %d CUs\n", per_cu, cus);
        grid = 256;
    }
    if (grid < 0) return;
    hipMemsetAsync((char*)d_ws + WS_CTL, 0, CTL_ZERO_BYTES, stream);
    Args a{};
    for (int i = 0; i < 26; ++i) a.in[i] = (const float*)d_in[i];
    a.out = (float*)d_out; a.ws = (unsigned char*)d_ws;
    for (int d = 0; d < 32; ++d) a.inv_freq[d] = powf(10000.0f, -(float)d / 32.0f);
    a.ph_lo = STAGE_LO; a.ph_hi = STAGE_HI;
    void* kargs[] = {&a};
    hipError_t e = hipLaunchCooperativeKernel((const void*)mk_fwd, dim3(grid), dim3(NTHREADS), kargs, LDS_BYTES, stream);
    if (e != hipSuccess) fprintf(stderr, "kernel_launch: cooperative launch failed: %s\n", hipGetErrorString(e));
}
```

```cpp
#include <hip/hip_runtime.h>
#include <hip/hip_cooperative_groups.h>
#include <cstdio>
#include <cmath>
namespace cg = cooperative_groups;

#define GAS __attribute__((address_space(1)))
#define LAS __attribute__((address_space(3)))
typedef unsigned short bf16_t;
typedef short bf16x8 __attribute__((ext_vector_type(8)));
typedef short s16x4 __attribute__((ext_vector_type(4)));
typedef _Float16 f16x8 __attribute__((ext_vector_type(8)));
typedef float f32x2 __attribute__((ext_vector_type(2)));
typedef float f32x4 __attribute__((ext_vector_type(4)));
typedef float f32x16 __attribute__((ext_vector_type(16)));
typedef unsigned u32x2 __attribute__((ext_vector_type(2)));
typedef unsigned u32x4 __attribute__((ext_vector_type(4)));
typedef GAS unsigned gu32;

#ifndef EXP6
#define EXP6 0
#endif
#ifndef STAGE_LO
#define STAGE_LO 0
#endif
#ifndef STAGE_HI
#define STAGE_HI 16
#endif
#ifndef ONLY
#define ONLY -1
#endif
#define STG(n) (ONLY < 0 || ONLY == (n))
#ifndef FFN1_COEF
#define FFN1_COEF 0.5f
#endif
#ifndef FFN2_COEF
#define FFN2_COEF 0.5f
#endif
#ifndef DBG_NO_FFN
#define DBG_NO_FFN 0
#endif
#ifndef DBG_SKIP_MIXER
#define DBG_SKIP_MIXER 0
#endif

constexpr int NB = 8, SEQ = 4096, DM = 1024, MROWS = NB * SEQ, DFF = 2816, NFF = 2 * DFF, NMIX = 4352, NMOD = 9 * DM;
constexpr float ALPHA = 1.189207115002721f;
constexpr float LN_EPS = 1e-5f;
constexpr float QSCALE = 0.125f * 1.4426950408889634f;
constexpr int NWAVES = 8, NTHREADS = 512;
constexpr int LDS_BYTES = 163840;

constexpr size_t MiB = 1u << 20;
constexpr size_t WS_CTL = 0, CTL_ZERO_BYTES = 65536;
constexpr size_t WS_MODP = 1 * MiB;
constexpr size_t WS_MOD = 3 * MiB + 512 * 1024;
constexpr size_t WS_ROPE = 4 * MiB;
constexpr size_t WS_BIAS1P = 5 * MiB;
constexpr size_t WS_WKVUP = 5 * MiB + 64 * 1024;
constexpr size_t WS_WC2K = 5 * MiB + 128 * 1024;
constexpr size_t WS_WC2V = 5 * MiB + 192 * 1024;
constexpr size_t WS_W1IN = 6 * MiB, WS_W1OUT = 17 * MiB, WS_W2IN = 23 * MiB, WS_W2OUT = 34 * MiB, WS_WMIX = 40 * MiB;
constexpr size_t WS_WBRA = 49 * MiB, WS_WBRB = 50 * MiB, WS_WMO = 51 * MiB, WS_WC1K = 53 * MiB, WS_WC1V = 54 * MiB;
constexpr size_t WS_U = 56 * MiB;
constexpr size_t WS_XR = 120 * MiB;
constexpr size_t WS_HF = 248 * MiB;
constexpr size_t WS_GATE = 248 * MiB, WS_QA = 376 * MiB, WS_QI = 408 * MiB;
constexpr size_t WS_MASK = 424 * MiB;
constexpr size_t WS_KC = 440 * MiB, WS_VC = 448 * MiB, WS_KS = 456 * MiB, WS_VST = 464 * MiB, WS_KW = 472 * MiB, WS_VWT = 480 * MiB;
constexpr size_t WS_HIDK = 488 * MiB, WS_HIDV = 490 * MiB, WS_KI = 492 * MiB, WS_KA = 496 * MiB, WS_VAT = 500 * MiB, WS_KVL = 504 * MiB;
constexpr size_t WS_END = 512 * MiB;
constexpr size_t DO_QB = 0, DO_GB = 32 * MiB, DO_WI = 35 * MiB, DO_KCMP = 36 * MiB, DO_VCMPT = 37 * MiB, DO_T = 64 * MiB;
constexpr int CW_QSEL = 64, CW_QDSA = 128, CW_QNSA = 192, CW_C2 = 256, CW_BAR = 4096;

struct Args { const float* in[26]; float* out; unsigned char* ws; float inv_freq[32]; int ph_lo, ph_hi; };

__device__ __forceinline__ unsigned cvt_pk_bf16(float lo, float hi) { unsigned r; asm volatile("v_cvt_pk_bf16_f32 %0, %1, %2" : "=v"(r) : "v"(lo), "v"(hi)); return r; }
__device__ __forceinline__ unsigned cvt_pk_f16(float lo, float hi) { typedef _Float16 h2 __attribute__((ext_vector_type(2))); h2 v; v.x = (_Float16)lo; v.y = (_Float16)hi; return __builtin_bit_cast(unsigned, v); }
__device__ __forceinline__ float bf2f(unsigned short b) { return __uint_as_float(((unsigned)b) << 16); }
__device__ __forceinline__ float sigmoidf_(float x) { return __builtin_amdgcn_rcpf(1.0f + __builtin_amdgcn_exp2f(-1.4426950408889634f * x)); }
__device__ __forceinline__ float siluf_(float x) { return x * __builtin_amdgcn_rcpf(1.0f + __builtin_amdgcn_exp2f(-1.4426950408889634f * x)); }
#define DPP_F(v, ctrl) __int_as_float(__builtin_amdgcn_update_dpp(0, __float_as_int(v), (ctrl), 0xF, 0xF, true))
__device__ __forceinline__ float dpp_xor1(float v) { return DPP_F(v, 0xB1); }
__device__ __forceinline__ float dpp_xor2(float v) { return DPP_F(v, 0x4E); }
__device__ __forceinline__ float swap32(float v, int hi) { const auto rr = __builtin_amdgcn_permlane32_swap(__float_as_uint(v), __float_as_uint(v), false, false); return __uint_as_float(hi ? rr[0] : rr[1]); }
__device__ __forceinline__ float max32(float v) { const auto rr = __builtin_amdgcn_permlane32_swap(__float_as_uint(v), __float_as_uint(v), false, false); return fmaxf(__uint_as_float(rr[0]), __uint_as_float(rr[1])); }
__device__ __forceinline__ float sum32(float v) { const auto rr = __builtin_amdgcn_permlane32_swap(__float_as_uint(v), __float_as_uint(v), false, false); return __uint_as_float(rr[0]) + __uint_as_float(rr[1]); }
__device__ __forceinline__ float wave_sum(float v) {
    v += dpp_xor1(v); v += dpp_xor2(v); v += DPP_F(v, 0x141); v += DPP_F(v, 0x140);
    { const auto rr = __builtin_amdgcn_permlane16_swap(__float_as_uint(v), __float_as_uint(v), false, false); v = __uint_as_float(rr[0]) + __uint_as_float(rr[1]); }
    return sum32(v);
}
#define LDS_WAIT() asm volatile("s_waitcnt lgkmcnt(0)" ::: "memory")
template <class T> __device__ __forceinline__ T* launder_ptr(T* p) {
    unsigned lo = (unsigned)(unsigned long long)p, hi = (unsigned)((unsigned long long)p >> 32);
    asm volatile("" : "+v"(lo), "+v"(hi));
    lo = (unsigned)__builtin_amdgcn_readfirstlane((int)lo); hi = (unsigned)__builtin_amdgcn_readfirstlane((int)hi);
    return (T*)(GAS T*)(((unsigned long long)hi << 32) | (unsigned long long)lo);
}

namespace pg8 {
#define PG8_LAS __attribute__((address_space(3)))
constexpr int BM = 256, BK = 64, HALF = 128, HTB = HALF * BK * 2, STAGE_BYTES = 8 * HTB, NXCD = 8, WGM = 8;
__host__ __device__ __forceinline__ int lds_byte(int r, int c) { const int st = (r >> 4) * 2 + (c >> 5), rr = r & 15, cc = c & 31, ob = rr * 64 + cc * 2; return st * 1024 + (ob ^ (((ob >> 9) & 1) << 5)); }
__host__ __device__ __forceinline__ void stage_rc(int b, int& R, int& C) { const int st = b / 1024, sb = b % 1024, swz = sb ^ (((sb >> 9) & 1) << 5); R = (st >> 1) * 16 + swz / 64; C = (st & 1) * 32 + (swz % 64) / 2; }
__host__ __device__ __forceinline__ int perm32(int rho) { const int n = rho >> 4, i = rho & 15; return 8 * (i >> 2) + 4 * n + (i & 3); }
struct Unit { int pm, pn; };
struct Gemm { const bf16_t* A; const bf16_t* Bt; int M, N, K, lda; };
struct StaticOrder {
    int nM, nN, nwg, G, c;
    __host__ __device__ void init(int M, int N, int G_, int c_) { nM = M / BM; nN = N / BM; nwg = nM * nN; G = G_; c = c_; }
    __host__ __device__ bool next(int i, Unit& u) const {
        if (c < 0) return false;
        const long L = (long)i * G + c; if (L >= nwg) return false;
        int wgid = (int)L; { const int q = nwg / NXCD, r = nwg % NXCD, xcd = wgid % NXCD, off = wgid / NXCD; wgid = (xcd < r ? xcd * (q + 1) : r * (q + 1) + (xcd - r) * q) + off; }
        const int nig = WGM * nN, gid = wgid / nig, fm = gid * WGM, gsz = (nM - fm) < WGM ? (nM - fm) : WGM;
        u.pm = fm + ((wgid % nig) % gsz); u.pn = (wgid % nig) / gsz; return true;
    }
};
template <class Epi, class Sched>
__device__ __forceinline__ void gemm_phase(PG8_LAS unsigned char* lds, const Gemm g, const Sched& S, const Epi& E) {
    int tid = threadIdx.x; asm volatile("" : "+v"(tid));
    const int wid = __builtin_amdgcn_readfirstlane(tid >> 6), lane = tid & 63, wr = wid >> 2, wc = wid & 3, fr = lane & 15, fq = lane >> 4;
    const int K = g.K, nt = K / BK, lda = g.lda;
    unsigned voffA[2], voffB[2];
#pragma unroll
    for (int i = 0; i < 2; ++i) { int R, C; stage_rc(tid * 16 + i * 8192, R, C); const int Rb = Epi::PERM ? ((R & ~31) + perm32(R & 31)) : R;
        voffA[i] = (unsigned)(R * lda + C) * 2u; voffB[i] = (unsigned)(Rb * K + C) * 2u; }
    const size_t kstep = (size_t)(BK * 2);
    const size_t hstepA = (size_t)HALF * lda * 2, hstepB = (size_t)HALF * K * 2;
    const size_t tstepA = 2 * hstepA, tstepB = 2 * hstepB;
    const unsigned ldsw = (unsigned)wid * 1024u;
    const int aoff = lds_byte(wr * 64 + fr, fq * 8), boff = lds_byte(wc * 32 + fr, fq * 8);
#define PG8_SA(b, h) (((b) * 2 + (h)) * HTB)
#define PG8_SB(b, h) ((4 + (b) * 2 + (h)) * HTB)
#define PG8_STAGE(bufoff, gbase, voff) do { _Pragma("unroll") for (int _i = 0; _i < 2; ++_i) \
        __builtin_amdgcn_global_load_lds((const unsigned*)((const char*)(gbase) + (voff)[_i]), (PG8_LAS unsigned*)(lds + (bufoff) + ldsw + _i * 8192), 16, 0, 0); } while (0)
#define PG8_LDA(dst, b, h) do { _Pragma("unroll") for (int m = 0; m < 4; ++m) _Pragma("unroll") for (int k = 0; k < 2; ++k) dst[m][k] = *(const PG8_LAS bf16x8*)(lds + PG8_SA(b, h) + aoff + m * 2048 + k * 1024); } while (0)
#define PG8_LDB(dst, b, h) do { _Pragma("unroll") for (int n = 0; n < 2; ++n) _Pragma("unroll") for (int k = 0; k < 2; ++k) dst[n][k] = *(const PG8_LAS bf16x8*)(lds + PG8_SB(b, h) + boff + n * 2048 + k * 1024); } while (0)
#define PG8_MMA(ai, bj, At, Bt) do { __builtin_amdgcn_s_setprio(1); _Pragma("unroll") for (int m = 0; m < 4; ++m) _Pragma("unroll") for (int n = 0; n < 2; ++n) _Pragma("unroll") for (int k = 0; k < 2; ++k) \
        acc[ai][bj][m][n] = __builtin_amdgcn_mfma_f32_16x16x32_bf16(Bt[n][k], At[m][k], acc[ai][bj][m][n], 0, 0, 0); __builtin_amdgcn_s_setprio(0); } while (0)
#define PG8_WAIT_V(n) asm volatile("s_waitcnt vmcnt(" #n ")" ::: "memory")
#define PG8_WAIT_L(n) asm volatile("s_waitcnt lgkmcnt(" #n ")" ::: "memory")
#define PG8_BAR __builtin_amdgcn_s_barrier()
#define PG8_SCHED __builtin_amdgcn_sched_barrier(0)
    Unit cur, nxt; int ui = 0;
    if (!S.next(0, cur)) return;
    f32x4 acc[2][2][4][2];
#pragma unroll
    for (int a = 0; a < 2; ++a)
#pragma unroll
        for (int b = 0; b < 2; ++b)
#pragma unroll
            for (int m = 0; m < 4; ++m)
#pragma unroll
                for (int n = 0; n < 2; ++n) acc[a][b][m][n] = (f32x4){0.f, 0.f, 0.f, 0.f};
    bf16x8 At[4][2], B0[2][2], B1[2][2];
    const char* cA = (const char*)g.A + (size_t)cur.pm * tstepA; const char* cB = (const char*)g.Bt + (size_t)cur.pn * tstepB;
    PG8_STAGE(PG8_SB(0, 0), cB, voffB); PG8_STAGE(PG8_SB(0, 1), cB + hstepB, voffB); PG8_STAGE(PG8_SA(0, 0), cA, voffA); PG8_STAGE(PG8_SA(0, 1), cA + hstepA, voffA);
    if (wr == 1) PG8_BAR;
    PG8_WAIT_V(2); PG8_BAR;
    PG8_STAGE(PG8_SB(1, 0), cB + kstep, voffB); PG8_STAGE(PG8_SA(1, 0), cA + kstep, voffA); PG8_STAGE(PG8_SB(1, 1), cB + hstepB + kstep, voffB);
    PG8_WAIT_V(6); PG8_BAR;
    for (;;) {
        const bool has_next = S.next(ui + 1, nxt);
        const char* nA = has_next ? (const char*)g.A + (size_t)nxt.pm * tstepA : cA; const char* nB = has_next ? (const char*)g.Bt + (size_t)nxt.pn * tstepB : cB;
        for (int t = 0; t < nt; t += 2) {
            const bool last = (t == nt - 2);
            const char* a1 = cA + (size_t)(t + 1) * kstep;
            const char* a2 = last ? nA : cA + (size_t)(t + 2) * kstep; const char* b2 = last ? nB : cB + (size_t)(t + 2) * kstep;
            const char* a3 = a2 + kstep; const char* b3 = b2 + kstep;
            PG8_LDB(B0, 0, 0); PG8_LDB(B1, 0, 1); PG8_SCHED; PG8_LDA(At, 0, 0); PG8_STAGE(PG8_SA(1, 1), a1 + hstepA, voffA);
            PG8_WAIT_V(8); PG8_WAIT_L(0); PG8_BAR; PG8_MMA(0, 0, At, B0); PG8_MMA(0, 1, At, B1); PG8_BAR; PG8_SCHED;
            PG8_LDA(At, 0, 1); PG8_STAGE(PG8_SB(0, 0), b2, voffB); PG8_STAGE(PG8_SB(0, 1), b2 + hstepB, voffB); PG8_STAGE(PG8_SA(0, 0), a2, voffA);
            PG8_WAIT_V(8); PG8_WAIT_L(0); PG8_BAR; PG8_MMA(1, 0, At, B0); PG8_MMA(1, 1, At, B1); PG8_BAR; PG8_SCHED;
            PG8_LDB(B0, 1, 0); PG8_LDB(B1, 1, 1); PG8_SCHED; PG8_LDA(At, 1, 0); PG8_STAGE(PG8_SA(0, 1), a2 + hstepA, voffA);
            PG8_WAIT_V(8); PG8_WAIT_L(0); PG8_BAR; PG8_MMA(0, 0, At, B0); PG8_MMA(0, 1, At, B1); PG8_BAR; PG8_SCHED;
            PG8_LDA(At, 1, 1); PG8_STAGE(PG8_SB(1, 0), b3, voffB); PG8_STAGE(PG8_SB(1, 1), b3 + hstepB, voffB); PG8_STAGE(PG8_SA(1, 0), a3, voffA);
            PG8_WAIT_V(8); PG8_WAIT_L(0); PG8_BAR; PG8_MMA(1, 0, At, B0); PG8_MMA(1, 1, At, B1); PG8_BAR; PG8_SCHED;
        }
        if (wr == 0) PG8_BAR;
        E(acc, cur, wr, wc, fr, fq);
        if (!has_next) break;
#pragma unroll
        for (int a = 0; a < 2; ++a)
#pragma unroll
            for (int b = 0; b < 2; ++b)
#pragma unroll
                for (int m = 0; m < 4; ++m)
#pragma unroll
                    for (int n = 0; n < 2; ++n) acc[a][b][m][n] = (f32x4){0.f, 0.f, 0.f, 0.f};
        cur = nxt; cA = nA; cB = nB; ++ui;
        if (wr == 1) PG8_BAR;
    }
    PG8_WAIT_V(0);
    PG8_BAR;
#undef PG8_SA
#undef PG8_SB
#undef PG8_STAGE
#undef PG8_LDA
#undef PG8_LDB
#undef PG8_MMA
#undef PG8_WAIT_V
#undef PG8_WAIT_L
#undef PG8_BAR
#undef PG8_SCHED
}
}

struct EpiSwiglu {
    static constexpr bool PERM = true;
    bf16_t* O;
    __device__ __forceinline__ void operator()(const f32x4 (&acc)[2][2][4][2], const pg8::Unit& u, int wr, int wc, int fr, int fq) const {
        asm volatile("" : "+v"(fr), "+v"(fq));
        const int row0 = u.pm * 256 + wr * 64 + fr, col0 = u.pn * 128 + wc * 32 + 8 * fq;
#pragma unroll
        for (int ai = 0; ai < 2; ++ai)
#pragma unroll
            for (int m = 0; m < 4; ++m) {
                bf16_t* rowp = O + (size_t)(row0 + ai * 128 + m * 16) * DFF + col0;
                float h[8];
#pragma unroll
                for (int n = 0; n < 2; ++n)
#pragma unroll
                    for (int j = 0; j < 4; ++j) h[n * 4 + j] = siluf_(acc[ai][0][m][n][j]) * acc[ai][1][m][n][j];
                u32x4 w; w.x = cvt_pk_bf16(h[0], h[1]); w.y = cvt_pk_bf16(h[2], h[3]); w.z = cvt_pk_bf16(h[4], h[5]); w.w = cvt_pk_bf16(h[6], h[7]);
                *(u32x4*)rowp = w;
            }
    }
};
template <bool XF32>
struct EpiResid {
    static constexpr bool PERM = true;
    const float* xres; const float* gmod; bf16_t* Y; const f32x2* stats; const float* lng; const float* lnb; float coef; int pad_;
    __device__ __forceinline__ void operator()(const f32x4 (&acc)[2][2][4][2], const pg8::Unit& u, int wr, int wc, int fr, int fq) const {
        asm volatile("" : "+v"(fr), "+v"(fq));
        const int row0 = u.pm * 256 + wr * 64 + fr, col0 = u.pn * 256 + wc * 32 + 8 * fq, b = u.pm >> 4;
        const float* gp = gmod + (size_t)b * NMOD + col0;
#pragma unroll
        for (int bj = 0; bj < 2; ++bj) {
            const f32x4 g0 = *(const f32x4*)(gp + bj * 128) * coef, g1 = *(const f32x4*)(gp + bj * 128 + 4) * coef;
            f32x4 a0 = (f32x4){1.f, 1.f, 1.f, 1.f}, a1 = a0, c0 = (f32x4){0.f, 0.f, 0.f, 0.f}, c1 = c0;
            if (!XF32) { a0 = *(const f32x4*)(lng + col0 + bj * 128); a1 = *(const f32x4*)(lng + col0 + bj * 128 + 4); c0 = *(const f32x4*)(lnb + col0 + bj * 128); c1 = *(const f32x4*)(lnb + col0 + bj * 128 + 4); }
#pragma unroll
            for (int ai = 0; ai < 2; ++ai) {
                {
                    f32x4 x0[4], x1[4]; f32x2 st[4];
#pragma unroll
                    for (int m = 0; m < 4; ++m) { const size_t row = (size_t)(row0 + ai * 128 + m * 16), off = row * DM + col0 + bj * 128;
                        if (XF32) { x0[m] = *(const f32x4*)(xres + off); x1[m] = *(const f32x4*)(xres + off + 4); }
                        else { const u32x4 w = *(const u32x4*)(Y + off); st[m] = stats[row];
                            x0[m] = (f32x4){__uint_as_float(w.x << 16), __uint_as_float(w.x & 0xffff0000u), __uint_as_float(w.y << 16), __uint_as_float(w.y & 0xffff0000u)};
                            x1[m] = (f32x4){__uint_as_float(w.z << 16), __uint_as_float(w.z & 0xffff0000u), __uint_as_float(w.w << 16), __uint_as_float(w.w & 0xffff0000u)}; } }
#pragma unroll
                    for (int m = 0; m < 4; ++m) { const size_t off = (size_t)(row0 + ai * 128 + m * 16) * DM + col0 + bj * 128;
                        f32x4 r0 = x0[m], r1 = x1[m];
                        if (!XF32) { r0 = (r0 - st[m].x) * st[m].y * a0 + c0; r1 = (r1 - st[m].x) * st[m].y * a1 + c1; }
                        const f32x4 y0 = r0 * ALPHA + g0 * acc[ai][bj][m][0], y1 = r1 * ALPHA + g1 * acc[ai][bj][m][1];
                        u32x4 w; w.x = cvt_pk_bf16(y0[0], y0[1]); w.y = cvt_pk_bf16(y0[2], y0[3]); w.z = cvt_pk_bf16(y1[0], y1[1]); w.w = cvt_pk_bf16(y1[2], y1[3]);
                        *(u32x4*)(Y + off) = w; }
                    asm volatile("" ::: "memory");
                }
            }
        }
    }
};
struct EpiGate {
    static constexpr bool PERM = true;
    const bf16_t* gate; int gcol0; const bf16_t* addsrc; bf16_t* O;
    __device__ __forceinline__ void operator()(const f32x4 (&acc)[2][2][4][2], const pg8::Unit& u, int wr, int wc, int fr, int fq) const {
        asm volatile("" : "+v"(fr), "+v"(fq));
        const int row0 = u.pm * 256 + wr * 64 + fr, col0 = u.pn * 256 + wc * 32 + 8 * fq;
#pragma unroll
        for (int ai = 0; ai < 2; ++ai) {
            u32x4 gw[4][2], aw[4][2];
#pragma unroll
            for (int m = 0; m < 4; ++m)
#pragma unroll
                for (int bj = 0; bj < 2; ++bj) { const size_t row = (size_t)(row0 + ai * 128 + m * 16); const int c = col0 + bj * 128;
                    gw[m][bj] = *(const u32x4*)(gate + row * 2048 + gcol0 + c);
                    if (addsrc) aw[m][bj] = *(const u32x4*)(addsrc + row * DM + c); }
#pragma unroll
            for (int m = 0; m < 4; ++m)
#pragma unroll
                for (int bj = 0; bj < 2; ++bj) { const size_t row = (size_t)(row0 + ai * 128 + m * 16); const int c = col0 + bj * 128;
                    float v[8];
#pragma unroll
                    for (int n = 0; n < 2; ++n)
#pragma unroll
                        for (int j = 0; j < 4; ++j) v[n * 4 + j] = acc[ai][bj][m][n][j];
#pragma unroll
                    for (int q = 0; q < 4; ++q) { v[2 * q] *= __uint_as_float(gw[m][bj][q] << 16); v[2 * q + 1] *= __uint_as_float(gw[m][bj][q] & 0xffff0000u); }
                    if (addsrc) {
#pragma unroll
                        for (int q = 0; q < 4; ++q) { v[2 * q] += __uint_as_float(aw[m][bj][q] << 16); v[2 * q + 1] += __uint_as_float(aw[m][bj][q] & 0xffff0000u); } }
                    u32x4 w; w.x = cvt_pk_bf16(v[0], v[1]); w.y = cvt_pk_bf16(v[2], v[3]); w.z = cvt_pk_bf16(v[4], v[5]); w.w = cvt_pk_bf16(v[6], v[7]);
                    *(u32x4*)(O + row * DM + c) = w; }
            asm volatile("" ::: "memory");
        }
    }
};
struct EpiCmp1 {
    static constexpr bool PERM = true;
    unsigned char* ws; int kv;
    __device__ __forceinline__ void operator()(const f32x4 (&acc)[2][2][4][2], const pg8::Unit& u, int wr, int wc, int fr, int fq) const {
        asm volatile("" : "+v"(fr), "+v"(fq));
        unsigned char* w_ = launder_ptr(ws);
        const float* bias1p = (const float*)(w_ + WS_BIAS1P) + (kv ? 8 * 256 : 0); bf16_t* O = (bf16_t*)(w_ + (kv ? WS_HIDV : WS_HIDK));
        const int row0 = u.pm * 256 + wr * 64 + fr, col0 = wc * 32 + 8 * fq;
        float bv[2][8];
#pragma unroll
        for (int bj = 0; bj < 2; ++bj)
#pragma unroll
            for (int e = 0; e < 8; ++e) { float s = 0.f;
#pragma unroll
                for (int kc = 0; kc < 8; ++kc) s += bias1p[kc * 256 + col0 + bj * 128 + e];
                bv[bj][e] = s; }
#pragma unroll
        for (int ai = 0; ai < 2; ++ai)
#pragma unroll
            for (int m = 0; m < 4; ++m) {
                const size_t row = (size_t)(row0 + ai * 128 + m * 16);
#pragma unroll
                for (int bj = 0; bj < 2; ++bj) {
                    float v[8];
#pragma unroll
                    for (int n = 0; n < 2; ++n)
#pragma unroll
                        for (int j = 0; j < 4; ++j) v[n * 4 + j] = siluf_(acc[ai][bj][m][n][j] + bv[bj][n * 4 + j]);
                    u32x4 w; w.x = cvt_pk_bf16(v[0], v[1]); w.y = cvt_pk_bf16(v[2], v[3]); w.z = cvt_pk_bf16(v[4], v[5]); w.w = cvt_pk_bf16(v[6], v[7]);
                    *(u32x4*)(O + row * 256 + col0 + bj * 128) = w;
                }
            }
    }
};
struct EpiMix {
    static constexpr bool PERM = true;
    unsigned char* ws_m; unsigned char* dout_m;
    __device__ __forceinline__ void operator()(const f32x4 (&acc)[2][2][4][2], const pg8::Unit& u, int wr, int wc, int fr, int fq) const {
        asm volatile("" : "+v"(fr), "+v"(fq));
        unsigned char* ws = launder_ptr(ws_m); unsigned char* dout = launder_ptr(dout_m);
        const f32x2* rope = (const f32x2*)(ws + WS_ROPE);
        const int slot = u.pn * 4 + wc, b = u.pm >> 4;
        const int t0 = (u.pm & 15) * 256 + wr * 64 + fr;
        int kind;
        bool rope_on = false, f16o = false, sig = false, kit = false; float scale = 1.f;
        unsigned short* dst = nullptr; int ld = 0, col0 = 0;
        if (slot < 8)       { kind = 0; rope_on = true; scale = QSCALE; dst = (unsigned short*)(ws + WS_QA) + (size_t)b * SEQ * 512; ld = 512; col0 = 64 * slot; }
        else if (slot < 12) { kind = 0; rope_on = true; f16o = true; dst = (unsigned short*)(ws + WS_QI) + (size_t)b * SEQ * 256; ld = 256; col0 = 64 * (slot - 8); }
        else if (slot < 20) { kind = 0; rope_on = true; scale = QSCALE; dst = (unsigned short*)(dout + DO_QB) + (size_t)b * SEQ * 512; ld = 512; col0 = 64 * (slot - 12); }
        else if (slot < 26) { kind = 0; rope_on = true; const int w = (slot - 20) >> 1, g = (slot - 20) & 1;
                              dst = (unsigned short*)(ws + (w == 0 ? WS_KC : (w == 1 ? WS_KS : WS_KW))) + (size_t)(b * 2 + g) * SEQ * 64; ld = 64; col0 = 0; }
        else if (slot == 26) { kind = 0; rope_on = true; f16o = true; kit = true; dst = (unsigned short*)(ws + WS_KI) + (size_t)b * SEQ * 64; ld = 64; col0 = 0; }
        else if (slot == 27) { kind = 2; }
        else if (slot < 30) { kind = 0; dst = (unsigned short*)(ws + WS_VC) + (size_t)(b * 2 + (slot - 28)) * SEQ * 64; ld = 64; col0 = 0; }
        else if (slot < 34) { kind = 1; const int w = (slot - 30) >> 1, g = (slot - 30) & 1; dst = (unsigned short*)(ws + (w == 0 ? WS_VST : WS_VWT)) + (size_t)(b * 2 + g) * 64 * SEQ; }
        else if (slot < 36) { kind = 0; dst = (unsigned short*)(ws + WS_KVL) + (size_t)b * SEQ * 128; ld = 128; col0 = 64 * (slot - 34); }
        else                { kind = 0; sig = true; dst = (unsigned short*)(ws + WS_GATE) + (size_t)b * SEQ * 2048; ld = 2048; col0 = 64 * (slot - 36); }
        if (kind == 0) {
#pragma unroll
            for (int ai = 0; ai < 2; ++ai)
#pragma unroll
                for (int m = 0; m < 4; ++m) {
                    const int t = t0 + ai * 128 + m * 16;
                    float x1[8], x2[8];
#pragma unroll
                    for (int n = 0; n < 2; ++n)
#pragma unroll
                        for (int j = 0; j < 4; ++j) { x1[n * 4 + j] = acc[ai][0][m][n][j]; x2[n * 4 + j] = acc[ai][1][m][n][j]; }
                    if (rope_on) {
                        const f32x4* rp = (const f32x4*)(rope + (size_t)t * 32 + 8 * fq);
#pragma unroll
                        for (int q = 0; q < 4; ++q) { const f32x4 cs = rp[q];
                            const float a0 = x1[2 * q], b0 = x2[2 * q], a1 = x1[2 * q + 1], b1 = x2[2 * q + 1];
                            x1[2 * q] = (a0 * cs[0] - b0 * cs[1]) * scale; x2[2 * q] = (a0 * cs[1] + b0 * cs[0]) * scale;
                            x1[2 * q + 1] = (a1 * cs[2] - b1 * cs[3]) * scale; x2[2 * q + 1] = (a1 * cs[3] + b1 * cs[2]) * scale; }
                    }
                    if (sig) {
#pragma unroll
                        for (int e = 0; e < 8; ++e) { x1[e] = sigmoidf_(x1[e]); x2[e] = sigmoidf_(x2[e]); }
                    }
                    u32x4 w1, w2;
                    if (f16o) { w1.x = cvt_pk_f16(x1[0], x1[1]); w1.y = cvt_pk_f16(x1[2], x1[3]); w1.z = cvt_pk_f16(x1[4], x1[5]); w1.w = cvt_pk_f16(x1[6], x1[7]);
                                w2.x = cvt_pk_f16(x2[0], x2[1]); w2.y = cvt_pk_f16(x2[2], x2[3]); w2.z = cvt_pk_f16(x2[4], x2[5]); w2.w = cvt_pk_f16(x2[6], x2[7]); }
                    else      { w1.x = cvt_pk_bf16(x1[0], x1[1]); w1.y = cvt_pk_bf16(x1[2], x1[3]); w1.z = cvt_pk_bf16(x1[4], x1[5]); w1.w = cvt_pk_bf16(x1[6], x1[7]);
                                w2.x = cvt_pk_bf16(x2[0], x2[1]); w2.y = cvt_pk_bf16(x2[2], x2[3]); w2.z = cvt_pk_bf16(x2[4], x2[5]); w2.w = cvt_pk_bf16(x2[6], x2[7]); }
                    unsigned short* rowp = kit ? dst + (size_t)(t >> 4) * 1024 + (fq * 16 + (t & 15)) * 8 : dst + (size_t)t * ld + col0 + 8 * fq;
                    *(u32x4*)rowp = w1; *(u32x4*)(rowp + (kit ? 512 : 32)) = w2;
                    asm volatile("" ::: "memory");
                }
        } else if (kind == 1) {
#pragma unroll
            for (int ai = 0; ai < 2; ++ai)
#pragma unroll
                for (int m = 0; m < 4; ++m) {
                    const int t = t0 + ai * 128 + m * 16;
#pragma unroll
                    for (int bj = 0; bj < 2; ++bj)
#pragma unroll
                        for (int n = 0; n < 2; ++n)
#pragma unroll
                            for (int j = 0; j < 4; ++j) { const int d = 32 * bj + 8 * fq + 4 * n + j;
                                dst[(size_t)(t >> 7) * 8192 + d * 128 + (t & 127)] = (unsigned short)(cvt_pk_bf16(acc[ai][bj][m][n][j], 0.f) & 0xffffu); }
                }
        } else {
            float* WI = (float*)(dout + DO_WI) + (size_t)b * SEQ * 4; float* GB = (float*)(dout + DO_GB) + (size_t)b * SEQ * 24;
#pragma unroll
            for (int ai = 0; ai < 2; ++ai)
#pragma unroll
                for (int m = 0; m < 4; ++m) {
                    const int t = t0 + ai * 128 + m * 16;
#pragma unroll
                    for (int n = 0; n < 2; ++n) { const int e0 = 8 * fq + 4 * n; const f32x4 v = acc[ai][0][m][n];
                        if (e0 == 0) { *(f32x4*)(WI + (size_t)t * 4) = v * 0.5f; }
                        else if (e0 < 28) { f32x4 s; s[0] = sigmoidf_(v[0]); s[1] = sigmoidf_(v[1]); s[2] = sigmoidf_(v[2]); s[3] = sigmoidf_(v[3]); *(f32x4*)(GB + (size_t)t * 24 + (e0 - 4)) = s; } }
                }
        }
    }
};

struct AttnAcc { f32x16 o0, o1; float m, l; };
__device__ __forceinline__ void attn_init(AttnAcc& A) {
#pragma unroll
    for (int r = 0; r < 16; ++r) { A.o0[r] = 0.f; A.o1[r] = 0.f; }
    A.m = -1e30f; A.l = 0.f;
}
__device__ __forceinline__ void attn_step(AttnAcc& A, const bf16x8 (&qf)[4], const bf16_t* __restrict__ Kp, const bf16_t* __restrict__ VTp, int ldv, unsigned vmask, int hi) {
    f32x16 s;
#pragma unroll
    for (int r = 0; r < 16; ++r) s[r] = 0.f;
#pragma unroll
    for (int ks = 0; ks < 4; ++ks) { const bf16x8 kf = *(const bf16x8*)(Kp + ks * 16); s = __builtin_amdgcn_mfma_f32_32x32x16_bf16(kf, qf[ks], s, 0, 0, 0); }
    s16x4 vf[2][2][2];
#pragma unroll
    for (int dt = 0; dt < 2; ++dt)
#pragma unroll
        for (int st = 0; st < 2; ++st) { vf[dt][st][0] = *(const s16x4*)(VTp + (size_t)dt * 32 * ldv + st * 16); vf[dt][st][1] = *(const s16x4*)(VTp + (size_t)dt * 32 * ldv + st * 16 + 8); }
    float mx = -INFINITY;
#pragma unroll
    for (int r = 0; r < 16; ++r) { const int ko = (r & 3) + 8 * (r >> 2) + 4 * hi; if (!((vmask >> ko) & 1u)) s[r] = -INFINITY; mx = fmaxf(mx, s[r]); }
    mx = max32(mx);
    const float mn = fmaxf(A.m, mx), alpha = __builtin_amdgcn_exp2f(A.m - mn); A.m = mn;
    float ls = 0.f;
#pragma unroll
    for (int r = 0; r < 16; ++r) { s[r] = __builtin_amdgcn_exp2f(s[r] - mn); ls += s[r]; }
    A.l = A.l * alpha + ls;
#pragma unroll
    for (int r = 0; r < 16; ++r) { A.o0[r] *= alpha; A.o1[r] *= alpha; }
    u32x4 p0, p1;
    p0.x = cvt_pk_bf16(s[0], s[1]); p0.y = cvt_pk_bf16(s[2], s[3]); p0.z = cvt_pk_bf16(s[4], s[5]); p0.w = cvt_pk_bf16(s[6], s[7]);
    p1.x = cvt_pk_bf16(s[8], s[9]); p1.y = cvt_pk_bf16(s[10], s[11]); p1.z = cvt_pk_bf16(s[12], s[13]); p1.w = cvt_pk_bf16(s[14], s[15]);
    const bf16x8 pb0 = __builtin_bit_cast(bf16x8, p0), pb1 = __builtin_bit_cast(bf16x8, p1);
#define VFR(dt, st) (bf16x8){vf[dt][st][0][0], vf[dt][st][0][1], vf[dt][st][0][2], vf[dt][st][0][3], vf[dt][st][1][0], vf[dt][st][1][1], vf[dt][st][1][2], vf[dt][st][1][3]}
    A.o0 = __builtin_amdgcn_mfma_f32_32x32x16_bf16(VFR(0, 0), pb0, A.o0, 0, 0, 0);
    A.o0 = __builtin_amdgcn_mfma_f32_32x32x16_bf16(VFR(0, 1), pb1, A.o0, 0, 0, 0);
    A.o1 = __builtin_amdgcn_mfma_f32_32x32x16_bf16(VFR(1, 0), pb0, A.o1, 0, 0, 0);
    A.o1 = __builtin_amdgcn_mfma_f32_32x32x16_bf16(VFR(1, 1), pb1, A.o1, 0, 0, 0);
#undef VFR
}
__device__ __forceinline__ float attn_inv_l(const AttnAcc& A) { const float l = sum32(A.l); return l > 0.f ? __builtin_amdgcn_rcpf(l) : 0.f; }
__device__ __forceinline__ void attn_store(const f32x16& o0, const f32x16& o1, bf16_t* yrow  , int hi) {
#pragma unroll
    for (int k4 = 0; k4 < 4; ++k4) {
        u32x2 w0, w1;
        w0.x = cvt_pk_bf16(o0[4 * k4], o0[4 * k4 + 1]); w0.y = cvt_pk_bf16(o0[4 * k4 + 2], o0[4 * k4 + 3]);
        w1.x = cvt_pk_bf16(o1[4 * k4], o1[4 * k4 + 1]); w1.y = cvt_pk_bf16(o1[4 * k4 + 2], o1[4 * k4 + 3]);
        *(u32x2*)(yrow + 8 * k4 + 4 * hi) = w0; *(u32x2*)(yrow + 32 + 8 * k4 + 4 * hi) = w1;
    }
}

#define XB_TMO      128
#define XB_XCNT(j)  (256  + 64 * (j))
#define XB_XSUB(j)  (1280 + 64 * (j))
#define XB_XGEN(j)  (2304 + 64 * (j))
#define XB_TOP      3328
#define XB_TOPGEN   3392
#define XCD_BAR_WORDS 3456
#define XB_SPIN_CAP (1u << 18)

__device__ __forceinline__ unsigned xb_ld(unsigned* p)              { return __hip_atomic_load(p, __ATOMIC_RELAXED, __HIP_MEMORY_SCOPE_AGENT); }
__device__ __forceinline__ unsigned xb_add(unsigned* p, unsigned v) { return __hip_atomic_fetch_add(p, v, __ATOMIC_RELAXED, __HIP_MEMORY_SCOPE_AGENT); }
__device__ __forceinline__ unsigned xb_xcc_id() { return (unsigned)__builtin_amdgcn_s_getreg((3 << 11) | 20) & 0xFu; }
#define XB_SPIN(cond, bar) do { unsigned _sp = 0; while (cond) { __builtin_amdgcn_s_sleep(1); \
    if ((++_sp & 255u) == 0u) { if (xb_ld(&(bar)[XB_TMO])) break; if (_sp > XB_SPIN_CAP) { atomicAdd(&(bar)[XB_TMO], 1u); break; } } } } while (0)

struct XcdBarrier {
    unsigned* bar; unsigned x;
    volatile LAS unsigned* st;
};

__device__ __forceinline__ XcdBarrier xcd_barrier_post(unsigned* bar, volatile LAS unsigned* st) {
    XcdBarrier b; b.bar = bar; b.x = xb_xcc_id(); b.st = st;
    if (threadIdx.x == 0) (void)xb_add(&bar[XB_XCNT(b.x)], 1u);
    return b;
}
__device__ __forceinline__ void xcd_barrier_complete(unsigned* bar, unsigned x, unsigned& nloc, unsigned& nx) {
    const unsigned G = gridDim.x * gridDim.y * gridDim.z;
    unsigned sum, cnt, mine, sp = 0u;
    for (;;) {
        sum = 0u; cnt = 0u; mine = 0u;
#pragma unroll
        for (unsigned j = 0; j < 16; ++j) { const unsigned c = xb_ld(&bar[XB_XCNT(j)]); sum += c; cnt += (c > 0u) ? 1u : 0u; mine = (j == x) ? c : mine; }
        if (sum == G) break;
        __builtin_amdgcn_s_sleep(1);
        if ((++sp & 255u) == 0u) { if (xb_ld(&bar[XB_TMO])) break; if (sp > XB_SPIN_CAP) { atomicAdd(&bar[XB_TMO], 1u); break; } }
    }
    nloc = mine > 0u ? mine : 1u; nx = cnt > 0u ? cnt : 1u;
}

__device__ __forceinline__ void xcd_barrier(const XcdBarrier& b) {
    asm volatile("s_waitcnt vmcnt(0)" ::: "memory");
    __syncthreads();
    if (threadIdx.x == 0) {
        unsigned* bar = b.bar;
        __builtin_amdgcn_s_waitcnt(0);
        unsigned nloc = b.st[0], nx = b.st[1];
        if (nloc == 0u) { xcd_barrier_complete(bar, b.x, nloc, nx); b.st[0] = nloc; b.st[1] = nx; }
        const unsigned old = xb_add(&bar[XB_XSUB(b.x)], 1u);
        const unsigned gen = old / nloc;
        if (old + 1u == (gen + 1u) * nloc) {
            __builtin_amdgcn_fence(__ATOMIC_RELEASE, "agent");
            asm volatile("s_waitcnt vmcnt(0)" ::: "memory");
            const unsigned og = xb_add(&bar[XB_TOP], 1u);
            const unsigned tg = og / nx;
            if (og + 1u == (tg + 1u) * nx) xb_add(&bar[XB_TOPGEN], 1u);
            else XB_SPIN(xb_ld(&bar[XB_TOPGEN]) == tg, bar);
            __builtin_amdgcn_fence(__ATOMIC_ACQUIRE, "agent");
            xb_add(&bar[XB_XGEN(b.x)], 1u);
            asm volatile("s_waitcnt vmcnt(0)" ::: "memory");
        } else {
            XB_SPIN(xb_ld(&bar[XB_XGEN(b.x)]) == gen, bar);
            __builtin_amdgcn_fence(__ATOMIC_ACQUIRE, "agent");
            asm volatile("s_waitcnt vmcnt(0)" ::: "memory");
        }
    }
    __syncthreads();
}

#define INP(k) ((const float*)(const GAS float*)(F.in[k]))
struct Frame {
    LAS unsigned char* lds; unsigned char* ws; unsigned char* dout; const float* const* in;
    int tid, lane, wave, G, blk;
};

__device__ __forceinline__ void transpose_item(const float* W, int K, int N, bf16_t* WT, int k0, int srccol, int dst_row0, LAS float* scr, int lane, const float* kscale) {
    const int sc_ = srccol < 0 ? 0 : srccol; float tv[32];
#pragma unroll
    for (int i = 0; i < 32; ++i) { const int kk = 2 * i + (lane >> 5); tv[i] = W[(size_t)(k0 + kk) * N + sc_]; }
#pragma unroll
    for (int i = 0; i < 32; ++i) { const int kk = 2 * i + (lane >> 5); float v = srccol >= 0 ? tv[i] : 0.f; if (kscale) v *= kscale[k0 + kk]; scr[kk * 33 + (lane & 31)] = v; }
    LDS_WAIT(); asm volatile("" ::: "memory");
    const int c = lane & 7;
#pragma unroll
    for (int j = 0; j < 4; ++j) { const int n = (lane >> 3) + 8 * j; const LAS float* s = scr + (8 * c) * 33 + n;
        u32x4 o; o.x = cvt_pk_bf16(s[0 * 33], s[1 * 33]); o.y = cvt_pk_bf16(s[2 * 33], s[3 * 33]); o.z = cvt_pk_bf16(s[4 * 33], s[5 * 33]); o.w = cvt_pk_bf16(s[6 * 33], s[7 * 33]);
        *(u32x4*)(WT + (size_t)(dst_row0 + n) * K + k0 + 8 * c) = o; }
    LDS_WAIT(); asm volatile("" ::: "memory");
}
__device__ __forceinline__ int mix_srccol(int slot, int bj, int e) {
    int base;
    if (slot < 8) base = 0 + 64 * slot;
    else if (slot < 12) base = 640 + 64 * (slot - 8);
    else if (slot < 20) base = 964 + 64 * (slot - 12);
    else if (slot < 22) base = 1476 + 64 * (slot - 20);
    else if (slot < 24) base = 1732 + 64 * (slot - 22);
    else if (slot < 26) base = 1988 + 64 * (slot - 24);
    else if (slot == 26) base = 896;
    else if (slot == 27) { if (bj == 1) return -1; if (e < 4) return 960 + e; if (e < 28) return 2244 + (e - 4); return -1; }
    else if (slot < 30) base = 1604 + 64 * (slot - 28);
    else if (slot < 32) base = 1860 + 64 * (slot - 30);
    else if (slot < 34) base = 2116 + 64 * (slot - 32);
    else if (slot < 36) base = 512 + 64 * (slot - 34);
    else base = 2268 + 64 * (slot - 36);
    return base + 32 * bj + e;
}
__device__ __forceinline__ void sincos_d(double x, float& sn, float& cs) {
    const double n = rint(x * 0.6366197723675814);
    double r = fma(-n, 1.5707963267341256, x); r = fma(-n, 6.077100506506192e-11, r);
    const double r2 = r * r;
    double sp = -7.647163731819816e-13; sp = fma(sp, r2, 1.6059043836821613e-10); sp = fma(sp, r2, -2.505210838544172e-08); sp = fma(sp, r2, 2.7557319223985893e-06);
    sp = fma(sp, r2, -0.0001984126984126984); sp = fma(sp, r2, 0.008333333333333333); sp = fma(sp, r2, -0.16666666666666666); sp = fma(sp * r2, r, r);
    double cp = 4.779477332387385e-14; cp = fma(cp, r2, -1.1470745597729725e-11); cp = fma(cp, r2, 2.08767569878681e-09); cp = fma(cp, r2, -2.755731922398589e-07);
    cp = fma(cp, r2, 2.48015873015873e-05); cp = fma(cp, r2, -0.001388888888888889); cp = fma(cp, r2, 0.041666666666666664); cp = fma(cp, r2, -0.5); cp = fma(cp, r2, 1.0);
    const int q = ((int)n) & 3;
    const double s_ = (q & 1) ? cp : sp, c_ = (q & 1) ? sp : cp;
    sn = (float)((q & 2) ? -s_ : s_); cs = (float)(((q + 1) & 2) ? -c_ : c_);
}

__device__ __forceinline__ void stage_prologue(Frame& F, const Args& args) {
    LAS float* scr = (LAS float*)(F.lds + F.wave * 8448);
    LAS float* cact = (LAS float*)(F.lds + 69632);
    const float* cin = INP(1);
    for (int i = F.tid; i < NB * DM; i += NTHREADS) cact[i] = siluf_(cin[i]);
    __syncthreads();
    const int gw = F.blk * NWAVES + F.wave, NGW = F.G * NWAVES;
    {
        const float* wada = INP(2); float* modp = (float*)(F.ws + WS_MODP);
        for (int it = gw; it < 144 * 8; it += NGW) {
            const int cgp = it % 144, kc = it / 144, n = cgp * 64 + F.lane;
            float a[8];
#pragma unroll
            for (int b = 0; b < 8; ++b) a[b] = 0.f;
#pragma unroll 32
            for (int k = kc * 128; k < kc * 128 + 128; ++k) { const float w = wada[(size_t)k * NMOD + n];
#pragma unroll
                for (int b = 0; b < 8; ++b) a[b] += cact[b * DM + k] * w; }
#pragma unroll
            for (int b = 0; b < 8; ++b) modp[((size_t)kc * 8 + b) * NMOD + n] = a[b];
        }
    }
    {
        float* b1p = (float*)(F.ws + WS_BIAS1P);
        for (int it = gw; it < 64; it += NGW) {
            const int kv = it >> 5, cgp = (it >> 3) & 3, kc = it & 7, n = cgp * 64 + F.lane;
            const float* pe = INP(kv ? 14 : 11); const float* w1 = INP(kv ? 15 : 12);
            float a = 0.f;
#pragma unroll 64
            for (int k = kc * 256; k < kc * 256 + 256; ++k) a += pe[k] * w1[(size_t)k * 256 + n];
            b1p[(kv * 8 + kc) * 256 + n] = a;
        }
    }
    {
        f32x2* rope = (f32x2*)(F.ws + WS_ROPE);
        for (int i = F.blk * NTHREADS + F.tid; i < SEQ * 32; i += F.G * NTHREADS) {
            const int pos = i >> 5, d = i & 31; const float ang = (float)pos * args.inv_freq[d];
            float sn, cs; sincos_d((double)ang, sn, cs); rope[i] = (f32x2){cs, sn};
        }
    }
    {
        constexpr int I_FIN = 16 * 176, I_FOUT = 44 * 32, I_MIX = 16 * 136, I_BR = 8 * 32, I_MO = 16 * 32, I_C1 = 32 * 8, I_C2 = 4 * 2, I_KV = 2 * 4;
        constexpr int NITEMS = I_FIN + I_FOUT + I_MIX + 2 * I_BR + I_MO + 2 * I_C1 + 2 * I_C2 + I_KV;
        for (int it = gw; it < NITEMS; it += NGW) {
            int r = it; const int l31 = F.lane & 31;
            if (r < I_FIN) { const int w = 0; const int kb = r / 176, ng = r % 176;
                const int pn = ng >> 3, half = (ng >> 2) & 1, sub = ng & 3; const int src = half * DFF + pn * 128 + sub * 32 + l31;
                transpose_item(INP(w ? 22 : 4), DM, NFF, (bf16_t*)(F.ws + (w ? WS_W2IN : WS_W1IN)), 64 * kb, src, 32 * ng, scr, F.lane, nullptr); continue; }
            r -= I_FIN;
            if (r < I_FOUT) { const int w = 0; const int kb = r / 32, ng = r % 32;
                transpose_item(INP(w ? 23 : 5), DFF, DM, (bf16_t*)(F.ws + (w ? WS_W2OUT : WS_W1OUT)), 64 * kb, 32 * ng + l31, 32 * ng, scr, F.lane, nullptr); continue; }
            r -= I_FOUT;
            if (r < I_MIX) { const int kb = r / 136, ng = r % 136; const int pn = ng >> 3, bj = (ng >> 2) & 1, wc = ng & 3;
                transpose_item(INP(8), DM, 4316, (bf16_t*)(F.ws + WS_WMIX), 64 * kb, mix_srccol(pn * 4 + wc, bj, l31), 32 * ng, scr, F.lane, nullptr); continue; }
            r -= I_MIX;
            if (r < 2 * I_BR) { const int w = r / I_BR; r -= w * I_BR; const int kb = r / 32, ng = r % 32;
                transpose_item(INP(w ? 18 : 17), 512, DM, (bf16_t*)(F.ws + (w ? WS_WBRB : WS_WBRA)), 64 * kb, 32 * ng + l31, 32 * ng, scr, F.lane, nullptr); continue; }
            r -= 2 * I_BR;
            if (r < I_MO) { const int kb = r / 32, ng = r % 32;
                transpose_item(INP(19), DM, DM, (bf16_t*)(F.ws + WS_WMO), 64 * kb, 32 * ng + l31, 32 * ng, scr, F.lane, nullptr); continue; }
            r -= I_MO;
            if (r < 2 * I_C1) { const int w = r / I_C1; r -= w * I_C1; const int kb = r / 8, ng = r % 8;
                transpose_item(INP(w ? 15 : 12), 2048, 256, (bf16_t*)(F.ws + (w ? WS_WC1V : WS_WC1K)), 64 * kb, 32 * ng + l31, 32 * ng, scr, F.lane, nullptr); continue; }
            r -= 2 * I_C1;
            if (r < 2 * I_C2) { const int w = r / I_C2; r -= w * I_C2; const int kb = r / 2, ng = r % 2;
                transpose_item(INP(w ? 16 : 13), 256, 64, (bf16_t*)(F.ws + (w ? WS_WC2V : WS_WC2K)), 64 * kb, 32 * ng + l31, 32 * ng, scr, F.lane, nullptr); continue; }
            r -= 2 * I_C2;
            { const int kb = r / 4, ng = r % 4;
                transpose_item(INP(10), 128, 128, (bf16_t*)(F.ws + WS_WKVUP), 64 * kb, 32 * ng + l31, 32 * ng, scr, F.lane, INP(9)); }
        }
    }
}

__device__ __forceinline__ void ffn2_transposes(Frame& F, const Args& args, int gw, int ngw) {
    LAS float* scr = (LAS float*)(F.lds + F.wave * 8448);
    constexpr int I_FIN = 16 * 176, I_FOUT = 44 * 32;
    const int l31 = F.lane & 31;
    for (int it = gw; it < I_FIN + I_FOUT; it += ngw) {
        int r = it;
        if (r < I_FIN) { const int kb = r / 176, ng = r % 176; const int pn = ng >> 3, half = (ng >> 2) & 1, sub = ng & 3; const int src = half * DFF + pn * 128 + sub * 32 + l31;
            transpose_item(INP(22), DM, NFF, (bf16_t*)(F.ws + WS_W2IN), 64 * kb, src, 32 * ng, scr, F.lane, nullptr); continue; }
        r -= I_FIN;
        { const int kb = r / 32, ng = r % 32;
            transpose_item(INP(23), DFF, DM, (bf16_t*)(F.ws + WS_W2OUT), 64 * kb, 32 * ng + l31, 32 * ng, scr, F.lane, nullptr); }
    }
}

template <int MODE>
__device__ __forceinline__ void stage_rows(Frame& F, const bf16_t* src, float* dstf, f32x2* stats, bf16_t* dstu, const float* lng, const float* lnb, const float* sh, const float* sc) {
    const int b = F.blk >> 5;
    f32x4 g4[4], b4[4], sh4[4], sc4[4];
#pragma unroll
    for (int j = 0; j < 4; ++j) { const int c = 4 * F.lane + 256 * j;
        g4[j] = *(const f32x4*)(lng + c); b4[j] = *(const f32x4*)(lnb + c);
        if (MODE != 2) { sh4[j] = *(const f32x4*)(sh + (size_t)b * NMOD + c); sc4[j] = *(const f32x4*)(sc + (size_t)b * NMOD + c) + 1.0f; } }
    const size_t row0 = (size_t)F.blk * 128 + F.wave * 16;
    u32x2 buf[2][8][4];
#pragma unroll
    for (int r = 0; r < 8; ++r)
#pragma unroll
        for (int j = 0; j < 4; ++j) buf[0][r][j] = __builtin_nontemporal_load((const u32x2*)(src + (row0 + r) * DM + 4 * F.lane + 256 * j));
#pragma unroll
    for (int g = 0; g < 2; ++g) {
        if (g < 1) {
#pragma unroll
            for (int r = 0; r < 8; ++r)
#pragma unroll
                for (int j = 0; j < 4; ++j) buf[1][r][j] = __builtin_nontemporal_load((const u32x2*)(src + (row0 + 8 + r) * DM + 4 * F.lane + 256 * j));
        }
#pragma unroll
        for (int r = 0; r < 8; ++r) {
            const size_t row = row0 + 8 * g + r;
            f32x4 v[4];
#pragma unroll
            for (int j = 0; j < 4; ++j) { const u32x2 w = buf[g][r][j]; v[j] = (f32x4){__uint_as_float(w.x << 16), __uint_as_float(w.x & 0xffff0000u), __uint_as_float(w.y << 16), __uint_as_float(w.y & 0xffff0000u)}; }
            float s = 0.f;
#pragma unroll
            for (int j = 0; j < 4; ++j) s += (v[j][0] + v[j][1]) + (v[j][2] + v[j][3]);
            const float mean = wave_sum(s) * (1.0f / DM); float s2 = 0.f;
#pragma unroll
            for (int j = 0; j < 4; ++j) { v[j] = v[j] - mean; s2 += (v[j][0] * v[j][0] + v[j][1] * v[j][1]) + (v[j][2] * v[j][2] + v[j][3] * v[j][3]); }
            const float rstd = __builtin_amdgcn_rsqf(wave_sum(s2) * (1.0f / DM) + LN_EPS);
            if (MODE != 2 && F.lane == 0) stats[row] = (f32x2){mean, rstd};
#pragma unroll
            for (int j = 0; j < 4; ++j) { v[j] = v[j] * rstd * g4[j] + b4[j];
                if (MODE == 2) __builtin_nontemporal_store(v[j], (f32x4*)(dstf + row * DM + 4 * F.lane + 256 * j)); }
            if (MODE != 2) {
#pragma unroll
                for (int j = 0; j < 4; ++j) { const f32x4 u = v[j] * sc4[j] + sh4[j]; u32x2 w; w.x = cvt_pk_bf16(u[0], u[1]); w.y = cvt_pk_bf16(u[2], u[3]);
                    __builtin_nontemporal_store(w, (u32x2*)(dstu + row * DM + 4 * F.lane + 256 * j)); }
            }
        }
    }
}
__device__ __forceinline__ void stage_mod_u1(Frame& F) {
    const float* modp = (const float*)(F.ws + WS_MODP); float* mod = (float*)(F.ws + WS_MOD); const float* bada = INP(3);
    const int b = F.blk >> 5, sl = F.blk & 31;
    LAS float* shsc = (LAS float*)F.lds;
    for (int i = F.tid; i < 2048; i += NTHREADS) { float s = bada[i];
#pragma unroll
        for (int kc = 0; kc < 8; ++kc) s += modp[((size_t)kc * 8 + b) * NMOD + i];
        shsc[i] = s; }
    for (int i = F.tid; i < 288; i += NTHREADS) { const int n = sl * 288 + i; float s = bada[n];
#pragma unroll
        for (int kc = 0; kc < 8; ++kc) s += modp[((size_t)kc * 8 + b) * NMOD + n];
        mod[(size_t)b * NMOD + n] = s; }
    __syncthreads();
    const float* x = INP(0); bf16_t* U = (bf16_t*)(F.ws + WS_U);
    f32x4 sh4[4], sc4[4];
#pragma unroll
    for (int j = 0; j < 4; ++j) { const int c = 4 * F.lane + 256 * j; sh4[j] = *(const LAS f32x4*)(shsc + c); sc4[j] = *(const LAS f32x4*)(shsc + 1024 + c) + 1.0f; }
    for (int g = 0; g < 2; ++g) {
        const size_t rowg = (size_t)F.blk * 128 + F.wave * 16 + 8 * g;
        f32x4 xv[8][4];
#pragma unroll
        for (int r = 0; r < 8; ++r)
#pragma unroll
            for (int j = 0; j < 4; ++j) xv[r][j] = __builtin_nontemporal_load((const f32x4*)(x + (rowg + r) * DM + 4 * F.lane + 256 * j));
#pragma unroll
        for (int r = 0; r < 8; ++r)
#pragma unroll
            for (int j = 0; j < 4; ++j) { const f32x4 u = xv[r][j] * sc4[j] + sh4[j];
                u32x2 w; w.x = cvt_pk_bf16(u[0], u[1]); w.y = cvt_pk_bf16(u[2], u[3]); __builtin_nontemporal_store(w, (u32x2*)(U + (rowg + r) * DM + 4 * F.lane + 256 * j)); }
    }
    __syncthreads();
}

__device__ __forceinline__ void kvup_item(Frame& F, int it) {
    int lane = F.lane; asm volatile("" : "+v"(lane)); const int l31 = lane & 31, hi = lane >> 5;
    const size_t row = (size_t)it * 32 + l31; const int b = (it * 32) >> 12, t = (int)(row & 4095);
    const bf16_t* kvl = (const bf16_t*)(F.ws + WS_KVL) + row * 128 + hi * 8;
    const bf16_t* W = (const bf16_t*)(F.ws + WS_WKVUP);
    bf16x8 xf[8]; float ss = 0.f;
#pragma unroll
    for (int ks = 0; ks < 8; ++ks) { xf[ks] = *(const bf16x8*)(kvl + ks * 16);
#pragma unroll
        for (int j = 0; j < 8; ++j) { const float v = bf2f((unsigned short)xf[ks][j]); ss += v * v; } }
    ss = sum32(ss);
    const float rstd = __builtin_amdgcn_rsqf(ss * (1.0f / 128.0f) + LN_EPS);
    const f32x2* rope = (const f32x2*)(F.ws + WS_ROPE) + (size_t)t * 32;
    bf16_t* ka = (bf16_t*)(F.ws + WS_KA) + row * 64; bf16_t* vat = (bf16_t*)(F.ws + WS_VAT) + (size_t)b * 64 * SEQ + (size_t)(t >> 7) * 8192 + (t & 127);
#pragma unroll
    for (int half = 0; half < 2; ++half) {
        f32x16 acc[2];
#pragma unroll
        for (int q = 0; q < 2; ++q) {
            const int nt = half * 2 + q;
#pragma unroll
            for (int r = 0; r < 16; ++r) acc[q][r] = 0.f;
            const bf16_t* wp = W + (size_t)(nt * 32 + l31) * 128 + hi * 8; asm volatile("" : "+v"(wp));
#pragma unroll
            for (int ks = 0; ks < 8; ++ks) { const bf16x8 wf = *(const bf16x8*)(wp + ks * 16); acc[q] = __builtin_amdgcn_mfma_f32_32x32x16_bf16(wf, xf[ks], acc[q], 0, 0, 0); }
            asm volatile("" ::: "memory");
        }
        if (half == 0) {
#pragma unroll
            for (int k4 = 0; k4 < 4; ++k4) {
                float o1[4], o2[4];
#pragma unroll
                for (int j = 0; j < 4; ++j) { const int r = 4 * k4 + j, d = j + 8 * k4 + 4 * hi; const f32x2 cs = rope[d]; const float a = acc[0][r] * rstd, bb = acc[1][r] * rstd;
                    o1[j] = a * cs[0] - bb * cs[1]; o2[j] = a * cs[1] + bb * cs[0]; }
                u32x2 w1, w2; w1.x = cvt_pk_bf16(o1[0], o1[1]); w1.y = cvt_pk_bf16(o1[2], o1[3]); w2.x = cvt_pk_bf16(o2[0], o2[1]); w2.y = cvt_pk_bf16(o2[2], o2[3]);
                *(u32x2*)(ka + 8 * k4 + 4 * hi) = w1; *(u32x2*)(ka + 32 + 8 * k4 + 4 * hi) = w2;
            }
        } else {
#pragma unroll
            for (int q = 0; q < 2; ++q)
#pragma unroll
                for (int r = 0; r < 16; ++r) { const int d = q * 32 + (r & 3) + 8 * (r >> 2) + 4 * hi; vat[(size_t)d * 128] = (unsigned short)(cvt_pk_bf16(acc[q][r] * rstd, 0.f) & 0xffffu); }
        }
        asm volatile("" ::: "memory");
    }
}
__device__ __forceinline__ void cmp2_item(Frame& F, int it) {
    int lane = F.lane; asm volatile("" : "+v"(lane)); const int l31 = lane & 31, hi = lane >> 5; const int kv = it >> 7, rblk = it & 127;
    const size_t row = (size_t)rblk * 32 + l31;
    const bf16_t* hid = (const bf16_t*)(F.ws + (kv ? WS_HIDV : WS_HIDK)) + row * 256 + hi * 8;
    const bf16_t* W = (const bf16_t*)(F.ws + (kv ? WS_WC2V : WS_WC2K));
    f32x16 acc[2];
#pragma unroll
    for (int nt = 0; nt < 2; ++nt)
#pragma unroll
        for (int r = 0; r < 16; ++r) acc[nt][r] = 0.f;
#pragma unroll
    for (int ks = 0; ks < 16; ++ks) { const bf16x8 hf = *(const bf16x8*)(hid + ks * 16);
#pragma unroll
        for (int nt = 0; nt < 2; ++nt) { const bf16x8 wf = *(const bf16x8*)(W + (size_t)(nt * 32 + l31) * 256 + ks * 16 + hi * 8); acc[nt] = __builtin_amdgcn_mfma_f32_32x32x16_bf16(wf, hf, acc[nt], 0, 0, 0); } }
    if (kv == 0) {
        bf16_t* o = (bf16_t*)(F.dout + DO_KCMP) + row * 64;
#pragma unroll
        for (int nt = 0; nt < 2; ++nt)
#pragma unroll
            for (int k4 = 0; k4 < 4; ++k4) { u32x2 w; w.x = cvt_pk_bf16(acc[nt][4 * k4], acc[nt][4 * k4 + 1]); w.y = cvt_pk_bf16(acc[nt][4 * k4 + 2], acc[nt][4 * k4 + 3]); *(u32x2*)(o + nt * 32 + 8 * k4 + 4 * hi) = w; }
    } else {
        const int bg = (int)(row >> 8), c = (int)(row & 255);
        bf16_t* o = (bf16_t*)(F.dout + DO_VCMPT) + (size_t)bg * 64 * 256 + (size_t)(c >> 7) * 8192 + (c & 127);
#pragma unroll
        for (int nt = 0; nt < 2; ++nt)
#pragma unroll
            for (int r = 0; r < 16; ++r) { const int d = nt * 32 + (r & 3) + 8 * (r >> 2) + 4 * hi; o[(size_t)d * 128] = (unsigned short)(cvt_pk_bf16(acc[nt][r], 0.f) & 0xffffu); }
    }
}

constexpr int SEL_ROW = 4112;
__device__ __forceinline__ unsigned ord_key(float v) { unsigned u = __float_as_uint(v); if (u == 0x80000000u) u = 0u; return (u & 0x80000000u) ? ~u : (u | 0x80000000u); }
__device__ __forceinline__ void hist_zero(LAS unsigned* hist, int lane) {
#pragma unroll
    for (int i = 0; i < 8; ++i) *(LAS u32x4*)(hist + 36 * lane + 4 * i) = (u32x4){0u, 0u, 0u, 0u};
    LDS_WAIT(); asm volatile("" ::: "memory");
}
__device__ __forceinline__ void hist_add(LAS unsigned* hist, unsigned d) { __hip_atomic_fetch_add(hist + d + ((d >> 5) << 2), 1u, __ATOMIC_RELAXED, __HIP_MEMORY_SCOPE_WORKGROUP); }
__device__ __forceinline__ int dpp_prefix_sum(int x) {
    x += __builtin_amdgcn_update_dpp(0, x, 0x111, 0xF, 0xF, true);
    x += __builtin_amdgcn_update_dpp(0, x, 0x112, 0xF, 0xF, true);
    x += __builtin_amdgcn_update_dpp(0, x, 0x114, 0xF, 0xF, true);
    x += __builtin_amdgcn_update_dpp(0, x, 0x118, 0xF, 0xF, true);
    x += __builtin_amdgcn_update_dpp(0, x, 0x142, 0xA, 0xF, false);
    x += __builtin_amdgcn_update_dpp(0, x, 0x143, 0xC, 0xF, false);
    return x;
}
__device__ __forceinline__ unsigned hist_find(LAS unsigned* hist, int lane, unsigned& need) {
    LDS_WAIT(); asm volatile("" ::: "memory");
    unsigned lsum = 0u; const int g0 = 63 - lane;
#pragma unroll
    for (int i = 0; i < 8; ++i) { const u32x4 q4 = *(const LAS u32x4*)(hist + 36 * g0 + 4 * i); lsum += (q4.x + q4.y) + (q4.z + q4.w); }
    const unsigned suf = (unsigned)dpp_prefix_sum((int)lsum), above_lane = suf - lsum;
    const unsigned long long bal = __ballot((above_lane < need) && (suf >= need));
    const int src = bal ? (int)__builtin_ctzll(bal) : 0;
    const unsigned ab1 = (unsigned)__builtin_amdgcn_readlane((int)above_lane, src);
    const unsigned need1 = need - ab1;
    const int g0o = 63 - src, b0o = 32 * g0o;
    const unsigned cnt = (lane < 32) ? hist[36 * g0o + 31 - lane] : 0u;
    LDS_WAIT(); asm volatile("" ::: "memory");
    const unsigned pre = (unsigned)dpp_prefix_sum((int)cnt);
    const unsigned long long bal2 = __ballot((pre >= need1) && (pre - cnt < need1));
    const int l2 = bal2 ? (int)__builtin_ctzll(bal2) : 0;
    const unsigned ab2 = (unsigned)__builtin_amdgcn_readlane((int)(pre - cnt), l2);
    need = need1 - ab2;
    return (unsigned)(b0o + 31 - l2);
}
__device__ __forceinline__ void sel_gbar(LAS unsigned* cnt, unsigned& target, int lane) {
    LDS_WAIT(); asm volatile("" ::: "memory");
    if (lane == 0) __hip_atomic_fetch_add(cnt, 1u, __ATOMIC_RELAXED, __HIP_MEMORY_SCOPE_WORKGROUP);
    target += 4u;
    while (__hip_atomic_load(cnt, __ATOMIC_RELAXED, __HIP_MEMORY_SCOPE_WORKGROUP) < target) __builtin_amdgcn_s_sleep(1);
    asm volatile("" ::: "memory");
}
__device__ __forceinline__ void sel_scores4(Frame& F, LAS unsigned* S, int gw, int b, int t0) {
    int lane = F.lane; asm volatile("" : "+v"(lane));
    const int c = lane & 15, g = lane >> 4;
    const _Float16* QI = (const _Float16*)(F.ws + WS_QI) + ((size_t)b * SEQ + t0 + (c >> 2)) * 256 + (c & 3) * 64 + g * 8;
    const _Float16* KI = (const _Float16*)(F.ws + WS_KI) + (size_t)b * SEQ * 64 + (g * 16 + c) * 8;
    const f32x4 w4 = *(const f32x4*)((const float*)(F.dout + DO_WI) + ((size_t)b * SEQ + t0 + g) * 4);
    f16x8 qf[2];
#pragma unroll
    for (int ks = 0; ks < 2; ++ks) qf[ks] = *(const f16x8*)(QI + ks * 32);
    const int ntile = (t0 >> 4) + 1, tq = t0 + g;
    LAS unsigned* Sw = S + g * SEL_ROW + c;
    const int rot = (int)((((unsigned)(F.blk * 251 + (F.wave >> 2) * 127) & 0xffffu) * (unsigned)ntile) >> 16);
    for (int base = gw; base < ntile; base += 32) {
        f16x8 kf[8][2];
#pragma unroll
        for (int u = 0; u < 8; ++u) { const int li = base + 4 * u; int tile = li + rot; if (tile >= ntile) tile -= ntile;
            if (li < ntile) {
#pragma unroll
                for (int ks = 0; ks < 2; ++ks) kf[u][ks] = *(const f16x8*)(KI + (size_t)tile * 1024 + ks * 512); } }
#pragma unroll
        for (int u = 0; u < 8; ++u) { const int li = base + 4 * u; int tile = li + rot; if (tile >= ntile) tile -= ntile;
            if (li < ntile) {
                f32x4 sc = (f32x4){0.f, 0.f, 0.f, 0.f};
#pragma unroll
                for (int ks = 0; ks < 2; ++ks) sc = __builtin_amdgcn_mfma_f32_16x16x32_f16(qf[ks], kf[u][ks], sc, 0, 0, 0);
                const float INF_ = __builtin_inff();
                const float r0 = __builtin_amdgcn_fmed3f(sc[0], 0.f, INF_), r1 = __builtin_amdgcn_fmed3f(sc[1], 0.f, INF_);
                const float r2 = __builtin_amdgcn_fmed3f(sc[2], 0.f, INF_), r3 = __builtin_amdgcn_fmed3f(sc[3], 0.f, INF_);
                const float v = (r0 * w4[0] + r1 * w4[1]) + (r2 * w4[2] + r3 * w4[3]);
                Sw[tile * 16] = (tile * 16 + c <= tq) ? ord_key(v) : 0u; }
        }
    }
    const int ntile_pad = ((t0 + 4 + 511) >> 9) << 5;
    for (int tile = ntile + gw; tile < ntile_pad; tile += 4) Sw[tile * 16] = 0u;
}
__device__ __forceinline__ void sel_radix(Frame& F, LAS unsigned* row, int b, int t, int rep) {
    const int lane = F.lane;
#define SEL_PASS_SPARSE(COND, DIGIT) do { int ln_ = lane; asm volatile("" : "+v"(ln_)); const unsigned Lb_ = 4095u - (unsigned)ln_; hist_zero(hist, ln_); \
        _Pragma("unroll") for (int c8_ = 0; c8_ < 8; ++c8_) { if (512 * c8_ < n) { _Pragma("unroll") for (int i8_ = 0; i8_ < 8; ++i8_) { const int i = 8 * c8_ + i8_; const unsigned o = ord[i]; const unsigned L = Lb_ - 64u * (unsigned)i; (void)L; \
            const bool m_ = (COND); if (__ballot(m_) != 0ull) { if (m_) hist_add(hist, (DIGIT)); } } } } } while (0)
#define SEL_PASS(COND, DIGIT) do { int ln_ = lane; asm volatile("" : "+v"(ln_)); const unsigned Lb_ = 4095u - (unsigned)ln_; hist_zero(hist, ln_); \
        _Pragma("unroll") for (int c8_ = 0; c8_ < 8; ++c8_) { if (512 * c8_ < n) { _Pragma("unroll") for (int i8_ = 0; i8_ < 8; ++i8_) { const int i = 8 * c8_ + i8_; const unsigned o = ord[i]; const unsigned L = Lb_ - 64u * (unsigned)i; (void)L; if (COND) hist_add(hist, (DIGIT)); } } } } while (0)
    {
        const int n = (rep && (EXP6 & 2)) ? 1 : (t + 1);
        unsigned ord[64];
        { int ln_ = lane; asm volatile("" : "+v"(ln_)); const LAS unsigned* rp = row + ln_;
#pragma unroll
          for (int c8 = 0; c8 < 8; ++c8) {
              if (512 * c8 < n) {
#pragma unroll
                  for (int i8 = 0; i8 < 8; ++i8) { const int i = 8 * c8 + i8; ord[i] = rp[64 * i]; }
              } else {
#pragma unroll
                  for (int i8 = 0; i8 < 8; ++i8) ord[8 * c8 + i8] = 0u;
              } } }
        LDS_WAIT(); asm volatile("" ::: "memory");
        unsigned Hs = 1u, Ls = 0u;
        if (n > 256) {
            LAS unsigned* hist = row;
            unsigned need = 256u;
            SEL_PASS(true, o >> 21);
            const unsigned d0 = hist_find(hist, lane, need);
            SEL_PASS((o >> 21) == d0, (o >> 10) & 2047u);
            const unsigned d1 = hist_find(hist, lane, need);
            const unsigned P2 = (d0 << 11) | d1;
            SEL_PASS_SPARSE((o >> 10) == P2, o & 1023u);
            const unsigned d2 = hist_find(hist, lane, need);
            Hs = (P2 << 10) | d2;
            const unsigned ties = hist[d2 + ((d2 >> 5) << 2)];
            LDS_WAIT(); asm volatile("" ::: "memory");
            if ((unsigned)__builtin_amdgcn_readfirstlane((int)ties) != need) {
                SEL_PASS(o == Hs, L >> 1);
                const unsigned t1 = hist_find(hist, lane, need);
                SEL_PASS_SPARSE(o == Hs && (L >> 1) == t1, L & 1u);
                const unsigned t2 = hist_find(hist, lane, need);
                Ls = (t1 << 1) | t2;
            }
        }
        unsigned mlo = 0u, mhi = 0u;
#define SEL_EMIT(SELEXPR) do { int ln_ = lane; asm volatile("" : "+v"(ln_)); const unsigned Lb_ = 4095u - (unsigned)ln_; \
          _Pragma("unroll") for (int c8 = 0; c8 < 8; ++c8) { if (512 * c8 < n) { \
            _Pragma("unroll") for (int i8 = 0; i8 < 8; ++i8) { const int i = 8 * c8 + i8; const unsigned L = Lb_ - 64u * (unsigned)i; (void)L; \
              const bool sel = (SELEXPR); \
              const unsigned long long bal = __ballot(sel); \
              const unsigned blo = (unsigned)bal, bhi = (unsigned)(bal >> 32); \
              asm("s_nop 1\n\tv_writelane_b32 %0, %2, %4\n\tv_writelane_b32 %1, %3, %4" : "+v"(mlo), "+v"(mhi) : "s"(blo), "s"(bhi), "n"(i)); } } } } while (0)
        if (__builtin_amdgcn_readfirstlane((int)Ls) == 0) SEL_EMIT(ord[i] >= Hs);
        else SEL_EMIT(ord[i] > Hs || (ord[i] == Hs && L >= Ls));
#undef SEL_EMIT
        u32x2* mrow = (u32x2*)(rep ? (F.dout + 96 * MiB) : (F.ws + WS_MASK)) + ((size_t)b * SEQ + t) * 64;
        mrow[lane] = (u32x2){mlo, mhi};
    }
#undef SEL_PASS
#undef SEL_PASS_SPARSE
}

constexpr int CH_KSTR = 144, CH_VSTR = 264, CH_KB = 128 * CH_KSTR, CH_VB = 64 * CH_VSTR, CH_BYTES = CH_KB + CH_VB;
struct ChunkRegs { u32x4 k[2], v[2]; };
__device__ __forceinline__ void chunk_load(ChunkRegs& R, const bf16_t* Kbase, const bf16_t* VTbase, int ldv, int k0, int k1, int tid) {
#pragma unroll
    for (int i = 0; i < 2; ++i) { const int p = tid + 512 * i, row = p >> 3, c16 = p & 7; const int key = (row < 64) ? (k0 + row) : (k1 + row - 64);
        R.k[i] = *(const u32x4*)(Kbase + (size_t)key * 64 + c16 * 8); }
#pragma unroll
    for (int i = 0; i < 2; ++i) { const int p = tid + 512 * i, d = p >> 4, c16 = p & 15; const int ks = ((c16 < 8) ? k0 : k1) + (c16 & 7) * 8;
        R.v[i] = *(const u32x4*)(VTbase + (size_t)(ks >> 7) * 8192 + d * 128 + (ks & 127)); }
}
__device__ __forceinline__ void chunk_store(const ChunkRegs& R, LAS unsigned char* buf, int tid) {
#pragma unroll
    for (int i = 0; i < 2; ++i) { const int p = tid + 512 * i, row = p >> 3, c16 = p & 7; *(LAS u32x4*)(buf + row * CH_KSTR + c16 * 16) = R.k[i]; }
#pragma unroll
    for (int i = 0; i < 2; ++i) { const int p = tid + 512 * i, d = p >> 4, c16 = p & 15; LAS unsigned char* q = buf + CH_KB + d * CH_VSTR + c16 * 16;
        *(LAS u32x2*)q = (u32x2){R.v[i].x, R.v[i].y}; *(LAS u32x2*)(q + 8) = (u32x2){R.v[i].z, R.v[i].w}; }
}
__device__ __forceinline__ f32x16 qk_tile_lds(const bf16x8 (&qf)[4], const LAS unsigned char* buf, int tl, int l31, int hi) {
    f32x16 s;
#pragma unroll
    for (int r = 0; r < 16; ++r) s[r] = 0.f;
    const LAS unsigned char* kp = buf + (tl * 32 + l31) * CH_KSTR + hi * 16;
#pragma unroll
    for (int ks = 0; ks < 4; ++ks) { const bf16x8 kf = *(const LAS bf16x8*)(kp + ks * 32); s = __builtin_amdgcn_mfma_f32_32x32x16_bf16(kf, qf[ks], s, 0, 0, 0); }
    return s;
}
__device__ __forceinline__ void pv_tile_lds(f32x16& o0, f32x16& o1, const LAS unsigned char* buf, int tl, int l31, int hi, bf16x8 pb0, bf16x8 pb1) {
    const LAS unsigned char* vp = buf + CH_KB + l31 * CH_VSTR + (tl * 32 + 4 * hi) * 2;
#pragma unroll
    for (int dt = 0; dt < 2; ++dt)
#pragma unroll
        for (int st = 0; st < 2; ++st) {
            const s16x4 a = *(const LAS s16x4*)(vp + dt * 32 * CH_VSTR + st * 32), c2 = *(const LAS s16x4*)(vp + dt * 32 * CH_VSTR + st * 32 + 16);
            const bf16x8 vf = (bf16x8){a[0], a[1], a[2], a[3], c2[0], c2[1], c2[2], c2[3]};
            if (dt == 0) o0 = __builtin_amdgcn_mfma_f32_32x32x16_bf16(vf, st ? pb1 : pb0, o0, 0, 0, 0); else o1 = __builtin_amdgcn_mfma_f32_32x32x16_bf16(vf, st ? pb1 : pb0, o1, 0, 0, 0);
        }
}
__device__ __forceinline__ void attn_step_lds(AttnAcc& A, const bf16x8 (&qf)[4], const LAS unsigned char* buf, int tl, unsigned vmask, int l31, int hi) {
    f32x16 s = qk_tile_lds(qf, buf, tl, l31, hi);
    const int vm = (int)(vmask >> (4 * hi));
    float m0 = fmaxf(fmaxf(s[0], s[1]), s[2]), m1 = fmaxf(fmaxf(s[3], s[4]), s[5]), m2 = fmaxf(fmaxf(s[6], s[7]), s[8]), m3 = fmaxf(fmaxf(s[9], s[10]), s[11]);
    m0 = fmaxf(fmaxf(m0, s[12]), s[13]); m1 = fmaxf(fmaxf(m1, s[14]), s[15]);
    float mx = max32(fmaxf(fmaxf(m0, m1), fmaxf(m2, m3)));
    if (__ballot(mx > A.m) != 0ull) {
        const float mn = fmaxf(A.m, mx), alpha = __builtin_amdgcn_exp2f(A.m - mn); A.m = mn;
        A.l *= alpha;
#pragma unroll
        for (int r = 0; r < 16; ++r) { A.o0[r] *= alpha; A.o1[r] *= alpha; }
    }
    f32x2 acc2[2] = {(f32x2){0.f, 0.f}, (f32x2){0.f, 0.f}};
    if (__ballot(vmask != 0u && vmask != 0xffffffffu) == 0ull) {
        const float nmv = (vmask != 0u) ? -A.m : -INFINITY;
        const f32x2 nm = (f32x2){nmv, nmv};
#pragma unroll
        for (int r = 0; r < 16; r += 2) {
            const f32x2 d = (f32x2){s[r], s[r + 1]} + nm;
            const float p0 = __builtin_amdgcn_exp2f(d.x), p1 = __builtin_amdgcn_exp2f(d.y);
            s[r] = p0; s[r + 1] = p1;
            acc2[(r >> 1) & 1] += (f32x2){p0, p1};
        }
    } else {
        const f32x2 nm = (f32x2){-A.m, -A.m};
#pragma unroll
        for (int r = 0; r < 16; r += 2) {
            const f32x2 d = (f32x2){s[r], s[r + 1]} + nm;
            const int b0 = (r & 3) + 8 * (r >> 2), b1 = ((r + 1) & 3) + 8 * ((r + 1) >> 2);
            const int t0 = __builtin_amdgcn_sbfe(vm, b0, 1), t1 = __builtin_amdgcn_sbfe(vm, b1, 1);
            const float p0 = __int_as_float(__float_as_int(__builtin_amdgcn_exp2f(d.x)) & t0), p1 = __int_as_float(__float_as_int(__builtin_amdgcn_exp2f(d.y)) & t1);
            s[r] = p0; s[r + 1] = p1;
            acc2[(r >> 1) & 1] += (f32x2){p0, p1};
        }
    }
    { const f32x2 t = acc2[0] + acc2[1]; A.l += t.x + t.y; }
    u32x4 p0, p1;
    p0.x = cvt_pk_bf16(s[0], s[1]); p0.y = cvt_pk_bf16(s[2], s[3]); p0.z = cvt_pk_bf16(s[4], s[5]); p0.w = cvt_pk_bf16(s[6], s[7]);
    p1.x = cvt_pk_bf16(s[8], s[9]); p1.y = cvt_pk_bf16(s[10], s[11]); p1.z = cvt_pk_bf16(s[12], s[13]); p1.w = cvt_pk_bf16(s[14], s[15]);
    pv_tile_lds(A.o0, A.o1, buf, tl, l31, hi, __builtin_bit_cast(bf16x8, p0), __builtin_bit_cast(bf16x8, p1));
}

__device__ __forceinline__ void attn_step_pair_lds(AttnAcc& A0, AttnAcc& A1, const bf16x8 (&qf)[4], const LAS unsigned char* buf, int tl0, int tl1, unsigned vmask0, unsigned vmask1, int l31, int hi) {
    f32x16 s0, s1;
#pragma unroll
    for (int r = 0; r < 16; ++r) { s0[r] = 0.f; s1[r] = 0.f; }
    const LAS unsigned char* kp0 = buf + (tl0 * 32 + l31) * CH_KSTR + hi * 16; const LAS unsigned char* kp1 = buf + (tl1 * 32 + l31) * CH_KSTR + hi * 16;
#pragma unroll
    for (int ks = 0; ks < 4; ++ks) { const bf16x8 k0 = *(const LAS bf16x8*)(kp0 + ks * 32), k1 = *(const LAS bf16x8*)(kp1 + ks * 32);
        s0 = __builtin_amdgcn_mfma_f32_32x32x16_bf16(k0, qf[ks], s0, 0, 0, 0); s1 = __builtin_amdgcn_mfma_f32_32x32x16_bf16(k1, qf[ks], s1, 0, 0, 0); }
    const int vm0 = (int)(vmask0 >> (4 * hi)), vm1 = (int)(vmask1 >> (4 * hi));
    float mxa, mxb;
    { float m0 = fmaxf(fmaxf(s0[0], s0[1]), s0[2]), m1 = fmaxf(fmaxf(s0[3], s0[4]), s0[5]), m2 = fmaxf(fmaxf(s0[6], s0[7]), s0[8]), m3 = fmaxf(fmaxf(s0[9], s0[10]), s0[11]);
      m0 = fmaxf(fmaxf(m0, s0[12]), s0[13]); m1 = fmaxf(fmaxf(m1, s0[14]), s0[15]); mxa = fmaxf(fmaxf(m0, m1), fmaxf(m2, m3)); }
    { float m0 = fmaxf(fmaxf(s1[0], s1[1]), s1[2]), m1 = fmaxf(fmaxf(s1[3], s1[4]), s1[5]), m2 = fmaxf(fmaxf(s1[6], s1[7]), s1[8]), m3 = fmaxf(fmaxf(s1[9], s1[10]), s1[11]);
      m0 = fmaxf(fmaxf(m0, s1[12]), s1[13]); m1 = fmaxf(fmaxf(m1, s1[14]), s1[15]); mxb = fmaxf(fmaxf(m0, m1), fmaxf(m2, m3)); }
    mxa = max32(mxa); mxb = max32(mxb);
    if (__ballot(mxa > A0.m || mxb > A1.m) != 0ull) {
        const float na = fmaxf(A0.m, mxa), nb = fmaxf(A1.m, mxb), aa = __builtin_amdgcn_exp2f(A0.m - na), ab = __builtin_amdgcn_exp2f(A1.m - nb);
        A0.m = na; A1.m = nb; A0.l *= aa; A1.l *= ab;
#pragma unroll
        for (int r = 0; r < 16; ++r) { A0.o0[r] *= aa; A0.o1[r] *= aa; A1.o0[r] *= ab; A1.o1[r] *= ab; }
    }
    const f32x2 na2 = (f32x2){-A0.m, -A0.m}, nb2 = (f32x2){-A1.m, -A1.m};
    f32x2 ca = (f32x2){0.f, 0.f}, cb = (f32x2){0.f, 0.f};
#pragma unroll
    for (int r = 0; r < 16; r += 2) {
        const f32x2 da = (f32x2){s0[r], s0[r + 1]} + na2, db = (f32x2){s1[r], s1[r + 1]} + nb2;
        const int b0 = (r & 3) + 8 * (r >> 2), b1 = ((r + 1) & 3) + 8 * ((r + 1) >> 2);
        const int ta0 = __builtin_amdgcn_sbfe(vm0, b0, 1), ta1 = __builtin_amdgcn_sbfe(vm0, b1, 1), tb0 = __builtin_amdgcn_sbfe(vm1, b0, 1), tb1 = __builtin_amdgcn_sbfe(vm1, b1, 1);
        const float pa0 = __int_as_float(__float_as_int(__builtin_amdgcn_exp2f(da.x)) & ta0), pa1 = __int_as_float(__float_as_int(__builtin_amdgcn_exp2f(da.y)) & ta1);
        const float pb0 = __int_as_float(__float_as_int(__builtin_amdgcn_exp2f(db.x)) & tb0), pb1 = __int_as_float(__float_as_int(__builtin_amdgcn_exp2f(db.y)) & tb1);
        s0[r] = pa0; s0[r + 1] = pa1; s1[r] = pb0; s1[r + 1] = pb1;
        ca += (f32x2){pa0, pa1}; cb += (f32x2){pb0, pb1};
    }
    A0.l += ca.x + ca.y; A1.l += cb.x + cb.y;
    u32x4 pa_0, pa_1, pb_0, pb_1;
    pa_0.x = cvt_pk_bf16(s0[0], s0[1]); pa_0.y = cvt_pk_bf16(s0[2], s0[3]); pa_0.z = cvt_pk_bf16(s0[4], s0[5]); pa_0.w = cvt_pk_bf16(s0[6], s0[7]);
    pa_1.x = cvt_pk_bf16(s0[8], s0[9]); pa_1.y = cvt_pk_bf16(s0[10], s0[11]); pa_1.z = cvt_pk_bf16(s0[12], s0[13]); pa_1.w = cvt_pk_bf16(s0[14], s0[15]);
    pb_0.x = cvt_pk_bf16(s1[0], s1[1]); pb_0.y = cvt_pk_bf16(s1[2], s1[3]); pb_0.z = cvt_pk_bf16(s1[4], s1[5]); pb_0.w = cvt_pk_bf16(s1[6], s1[7]);
    pb_1.x = cvt_pk_bf16(s1[8], s1[9]); pb_1.y = cvt_pk_bf16(s1[10], s1[11]); pb_1.z = cvt_pk_bf16(s1[12], s1[13]); pb_1.w = cvt_pk_bf16(s1[14], s1[15]);
    const bf16x8 fa0 = __builtin_bit_cast(bf16x8, pa_0), fa1 = __builtin_bit_cast(bf16x8, pa_1), fb0 = __builtin_bit_cast(bf16x8, pb_0), fb1 = __builtin_bit_cast(bf16x8, pb_1);
    const LAS unsigned char* vp0 = buf + CH_KB + l31 * CH_VSTR + (tl0 * 32 + 4 * hi) * 2; const LAS unsigned char* vp1 = buf + CH_KB + l31 * CH_VSTR + (tl1 * 32 + 4 * hi) * 2;
#pragma unroll
    for (int dt = 0; dt < 2; ++dt)
#pragma unroll
        for (int st = 0; st < 2; ++st) {
            const s16x4 a = *(const LAS s16x4*)(vp0 + dt * 32 * CH_VSTR + st * 32), c2 = *(const LAS s16x4*)(vp0 + dt * 32 * CH_VSTR + st * 32 + 16);
            const s16x4 e = *(const LAS s16x4*)(vp1 + dt * 32 * CH_VSTR + st * 32), f2 = *(const LAS s16x4*)(vp1 + dt * 32 * CH_VSTR + st * 32 + 16);
            const bf16x8 va = (bf16x8){a[0], a[1], a[2], a[3], c2[0], c2[1], c2[2], c2[3]}, vb = (bf16x8){e[0], e[1], e[2], e[3], f2[0], f2[1], f2[2], f2[3]};
            if (dt == 0) { A0.o0 = __builtin_amdgcn_mfma_f32_32x32x16_bf16(va, st ? fa1 : fa0, A0.o0, 0, 0, 0); A1.o0 = __builtin_amdgcn_mfma_f32_32x32x16_bf16(vb, st ? fb1 : fb0, A1.o0, 0, 0, 0); }
            else         { A0.o1 = __builtin_amdgcn_mfma_f32_32x32x16_bf16(va, st ? fa1 : fa0, A0.o1, 0, 0, 0); A1.o1 = __builtin_amdgcn_mfma_f32_32x32x16_bf16(vb, st ? fb1 : fb0, A1.o1, 0, 0, 0); }
        }
}
__device__ __forceinline__ void attn_merge(AttnAcc& A0, const AttnAcc& A1) {
    const float mn = fmaxf(A0.m, A1.m), a0 = __builtin_amdgcn_exp2f(A0.m - mn), a1 = __builtin_amdgcn_exp2f(A1.m - mn);
    A0.m = mn; A0.l = A0.l * a0 + A1.l * a1;
#pragma unroll
    for (int r = 0; r < 16; ++r) { A0.o0[r] = A0.o0[r] * a0 + A1.o0[r] * a1; A0.o1[r] = A0.o1[r] * a0 + A1.o1[r] * a1; }
}

__device__ __forceinline__ void attn_step2_lds(AttnAcc& A0, AttnAcc& A1, const bf16x8 (&qa)[4], const bf16x8 (&qb)[4], const LAS unsigned char* buf, int tl, unsigned vmask, int l31, int hi) {
    f32x16 s0, s1;
#pragma unroll
    for (int r = 0; r < 16; ++r) { s0[r] = 0.f; s1[r] = 0.f; }
    const LAS unsigned char* kp = buf + (tl * 32 + l31) * CH_KSTR + hi * 16;
#pragma unroll
    for (int ks = 0; ks < 4; ++ks) { const bf16x8 kf = *(const LAS bf16x8*)(kp + ks * 32);
        s0 = __builtin_amdgcn_mfma_f32_32x32x16_bf16(kf, qa[ks], s0, 0, 0, 0); s1 = __builtin_amdgcn_mfma_f32_32x32x16_bf16(kf, qb[ks], s1, 0, 0, 0); }
    const int vm = (int)(vmask >> (4 * hi));
    float mxa, mxb;
    { float m0 = fmaxf(fmaxf(s0[0], s0[1]), s0[2]), m1 = fmaxf(fmaxf(s0[3], s0[4]), s0[5]), m2 = fmaxf(fmaxf(s0[6], s0[7]), s0[8]), m3 = fmaxf(fmaxf(s0[9], s0[10]), s0[11]);
      m0 = fmaxf(fmaxf(m0, s0[12]), s0[13]); m1 = fmaxf(fmaxf(m1, s0[14]), s0[15]); mxa = fmaxf(fmaxf(m0, m1), fmaxf(m2, m3)); }
    { float m0 = fmaxf(fmaxf(s1[0], s1[1]), s1[2]), m1 = fmaxf(fmaxf(s1[3], s1[4]), s1[5]), m2 = fmaxf(fmaxf(s1[6], s1[7]), s1[8]), m3 = fmaxf(fmaxf(s1[9], s1[10]), s1[11]);
      m0 = fmaxf(fmaxf(m0, s1[12]), s1[13]); m1 = fmaxf(fmaxf(m1, s1[14]), s1[15]); mxb = fmaxf(fmaxf(m0, m1), fmaxf(m2, m3)); }
    mxa = max32(mxa); mxb = max32(mxb);
    if (__ballot(mxa > A0.m || mxb > A1.m) != 0ull) {
        const float na = fmaxf(A0.m, mxa), nb = fmaxf(A1.m, mxb), aa = __builtin_amdgcn_exp2f(A0.m - na), ab = __builtin_amdgcn_exp2f(A1.m - nb);
        A0.m = na; A1.m = nb; A0.l *= aa; A1.l *= ab;
#pragma unroll
        for (int r = 0; r < 16; ++r) { A0.o0[r] *= aa; A0.o1[r] *= aa; A1.o0[r] *= ab; A1.o1[r] *= ab; }
    }
    const f32x2 na2 = (f32x2){-A0.m, -A0.m}, nb2 = (f32x2){-A1.m, -A1.m};
    f32x2 ca = (f32x2){0.f, 0.f}, cb = (f32x2){0.f, 0.f};
#pragma unroll
    for (int r = 0; r < 16; r += 2) {
        const f32x2 da = (f32x2){s0[r], s0[r + 1]} + na2, db = (f32x2){s1[r], s1[r + 1]} + nb2;
        const int b0 = (r & 3) + 8 * (r >> 2), b1 = ((r + 1) & 3) + 8 * ((r + 1) >> 2);
        const int t0 = __builtin_amdgcn_sbfe(vm, b0, 1), t1 = __builtin_amdgcn_sbfe(vm, b1, 1);
        const float pa0 = __int_as_float(__float_as_int(__builtin_amdgcn_exp2f(da.x)) & t0), pa1 = __int_as_float(__float_as_int(__builtin_amdgcn_exp2f(da.y)) & t1);
        const float pb0 = __int_as_float(__float_as_int(__builtin_amdgcn_exp2f(db.x)) & t0), pb1 = __int_as_float(__float_as_int(__builtin_amdgcn_exp2f(db.y)) & t1);
        s0[r] = pa0; s0[r + 1] = pa1; s1[r] = pb0; s1[r + 1] = pb1;
        ca += (f32x2){pa0, pa1}; cb += (f32x2){pb0, pb1};
    }
    A0.l += ca.x + ca.y; A1.l += cb.x + cb.y;
    u32x4 pa_0, pa_1, pb_0, pb_1;
    pa_0.x = cvt_pk_bf16(s0[0], s0[1]); pa_0.y = cvt_pk_bf16(s0[2], s0[3]); pa_0.z = cvt_pk_bf16(s0[4], s0[5]); pa_0.w = cvt_pk_bf16(s0[6], s0[7]);
    pa_1.x = cvt_pk_bf16(s0[8], s0[9]); pa_1.y = cvt_pk_bf16(s0[10], s0[11]); pa_1.z = cvt_pk_bf16(s0[12], s0[13]); pa_1.w = cvt_pk_bf16(s0[14], s0[15]);
    pb_0.x = cvt_pk_bf16(s1[0], s1[1]); pb_0.y = cvt_pk_bf16(s1[2], s1[3]); pb_0.z = cvt_pk_bf16(s1[4], s1[5]); pb_0.w = cvt_pk_bf16(s1[6], s1[7]);
    pb_1.x = cvt_pk_bf16(s1[8], s1[9]); pb_1.y = cvt_pk_bf16(s1[10], s1[11]); pb_1.z = cvt_pk_bf16(s1[12], s1[13]); pb_1.w = cvt_pk_bf16(s1[14], s1[15]);
    const bf16x8 fa0 = __builtin_bit_cast(bf16x8, pa_0), fa1 = __builtin_bit_cast(bf16x8, pa_1), fb0 = __builtin_bit_cast(bf16x8, pb_0), fb1 = __builtin_bit_cast(bf16x8, pb_1);
    const LAS unsigned char* vp = buf + CH_KB + l31 * CH_VSTR + (tl * 32 + 4 * hi) * 2;
#pragma unroll
    for (int dt = 0; dt < 2; ++dt)
#pragma unroll
        for (int st = 0; st < 2; ++st) {
            const s16x4 a = *(const LAS s16x4*)(vp + dt * 32 * CH_VSTR + st * 32), c2 = *(const LAS s16x4*)(vp + dt * 32 * CH_VSTR + st * 32 + 16);
            const bf16x8 vf = (bf16x8){a[0], a[1], a[2], a[3], c2[0], c2[1], c2[2], c2[3]};
            if (dt == 0) { A0.o0 = __builtin_amdgcn_mfma_f32_32x32x16_bf16(vf, st ? fa1 : fa0, A0.o0, 0, 0, 0); A1.o0 = __builtin_amdgcn_mfma_f32_32x32x16_bf16(vf, st ? fb1 : fb0, A1.o0, 0, 0, 0); }
            else         { A0.o1 = __builtin_amdgcn_mfma_f32_32x32x16_bf16(vf, st ? fa1 : fa0, A0.o1, 0, 0, 0); A1.o1 = __builtin_amdgcn_mfma_f32_32x32x16_bf16(vf, st ? fb1 : fb0, A1.o1, 0, 0, 0); }
        }
}
__device__ __forceinline__ void dsa_attn_unit(Frame& F, int b, int qt64, bf16_t* ybase) {
    const int lane = F.lane, l31 = lane & 31, hi = lane >> 5, sub = F.wave >> 2, hp = F.wave & 3, tid = F.tid;
    const int qt = 2 * qt64 + sub, t = qt * 32 + l31;
    const bf16_t* qrow = (const bf16_t*)(F.ws + WS_QA) + ((size_t)b * SEQ + t) * 512 + hp * 128;
    bf16x8 qa[4], qb[4];
#pragma unroll
    for (int ks = 0; ks < 4; ++ks) { qa[ks] = *(const bf16x8*)(qrow + ks * 16 + hi * 8); qb[ks] = *(const bf16x8*)(qrow + 64 + ks * 16 + hi * 8); }
    const bf16_t* K = (const bf16_t*)(F.ws + WS_KA) + (size_t)b * SEQ * 64;
    const bf16_t* VT = (const bf16_t*)(F.ws + WS_VAT) + (size_t)b * 64 * SEQ;
    AttnAcc A0, A1; attn_init(A0); attn_init(A1);
    const int nch = ((2 * qt64 + 1) >> 2) + 1;
    LAS u32x4* MW = (LAS u32x4*)(F.lds + 2 * CH_BYTES);
    const unsigned* mq = (const unsigned*)(F.ws + WS_MASK) + ((size_t)b * SEQ + qt64 * 64 + (tid & 63)) * 128;
    ChunkRegs R; u32x4 mreg = (u32x4){0u, 0u, 0u, 0u};
    chunk_load(R, K, VT, SEQ, 0, 64, tid); if (tid < 64) mreg = *(const u32x4*)(mq);
    chunk_store(R, F.lds, tid); if (tid < 64) MW[tid] = mreg;
    __syncthreads();
    for (int c = 0; c < nch; ++c) {
        const LAS unsigned char* buf = F.lds + (c & 1) * CH_BYTES;
        if (c + 1 < nch) { chunk_load(R, K, VT, SEQ, 128 * (c + 1), 128 * (c + 1) + 64, tid); if (tid < 64) mreg = *(const u32x4*)(mq + 4 * (c + 1)); }
        const u32x4 mw = MW[(c & 1) * 64 + sub * 32 + l31];
#pragma unroll
        for (int tl = 0; tl < 4; ++tl) { if (4 * c + tl <= qt) attn_step2_lds(A0, A1, qa, qb, buf, tl, mw[tl], l31, hi); }
        if (c + 1 < nch) { chunk_store(R, F.lds + ((c + 1) & 1) * CH_BYTES, tid); if (tid < 64) MW[((c + 1) & 1) * 64 + tid] = mreg; }
        __syncthreads();
    }
    bf16_t* yrow = ybase + ((size_t)b * SEQ + t) * 512 + hp * 128;
    { const float il = attn_inv_l(A0);
#pragma unroll
      for (int r = 0; r < 16; ++r) { A0.o0[r] *= il; A0.o1[r] *= il; }
      attn_store(A0.o0, A0.o1, yrow, hi); }
    { const float il = attn_inv_l(A1);
#pragma unroll
      for (int r = 0; r < 16; ++r) { A1.o0[r] *= il; A1.o1[r] *= il; }
      attn_store(A1.o0, A1.o1, yrow + 64, hi); }
}

constexpr int IMP_Q = 65;
constexpr int NSA_IMP_OFF = 2 * CH_BYTES, NSA_SEL_OFF = NSA_IMP_OFF + 2 * 4 * 32 * IMP_Q * 4, NSA_UNI_OFF = NSA_SEL_OFF + 512;
__device__ __forceinline__ void nsa_unit(Frame& F, int b, int g, int qt64, bf16_t* ybase) {
    int lane_ = F.lane, tid_ = F.tid; asm volatile("" : "+v"(lane_), "+v"(tid_));
    const int lane = lane_, l31 = lane & 31, hi = lane >> 5, sub = F.wave >> 2, rr = F.wave & 3, head = g * 4 + rr, tid = tid_;
    const int tsub = qt64 * 64 + sub * 32, t = tsub + l31;
    LAS float* IMP = (LAS float*)(F.lds + NSA_IMP_OFF);
    LAS unsigned long long* SELM = (LAS unsigned long long*)(F.lds + NSA_SEL_OFF);
    LAS unsigned* UNI = (LAS unsigned*)(F.lds + NSA_UNI_OFF);
    const bf16_t* qrow = (const bf16_t*)(F.dout + DO_QB) + ((size_t)b * SEQ + t) * 512 + head * 64;
    bf16x8 qf[4];
#pragma unroll
    for (int ks = 0; ks < 4; ++ks) qf[ks] = *(const bf16x8*)(qrow + ks * 16 + hi * 8);
    const float* gb = (const float*)(F.dout + DO_GB) + ((size_t)b * SEQ + t) * 24;
    const float g_c = gb[head], g_s = gb[8 + head], g_w = gb[16 + head];
    const int bg = b * 2 + g;
    f32x16 out0, out1;
    ChunkRegs R;
    {
        const bf16_t* K = (const bf16_t*)(F.dout + DO_KCMP) + (size_t)bg * 256 * 64;
        const bf16_t* VT = (const bf16_t*)(F.dout + DO_VCMPT) + (size_t)bg * 64 * 256;
        if (tid == 0) { UNI[0] = 0u; UNI[1] = 0u; }
        chunk_load(R, K, VT, 256, 0, 64, tid); chunk_store(R, F.lds, tid);
        chunk_load(R, K, VT, 256, 128, 192, tid); chunk_store(R, F.lds + CH_BYTES, tid);
        __syncthreads();
        const int cl = (t - 31) >> 4;
        const int clw = tsub >> 4;
        const int ntile = (clw >> 5) + 1;
        float m = -1e30f, l = 0.f;
        for (int tile = 0; tile < ntile; ++tile) {
            f32x16 s = qk_tile_lds(qf, F.lds + (tile >> 2) * CH_BYTES, tile & 3, l31, hi);
            float mx = -INFINITY;
#pragma unroll
            for (int r = 0; r < 16; ++r) { const int c = tile * 32 + (r & 3) + 8 * (r >> 2) + 4 * hi; if (c > cl) s[r] = -INFINITY; mx = fmaxf(mx, s[r]); }
            const float mn = fmaxf(m, mx); float ls = 0.f;
#pragma unroll
            for (int r = 0; r < 16; ++r) ls += __builtin_amdgcn_exp2f(s[r] - mn);
            l = l * __builtin_amdgcn_exp2f(m - mn) + ls; m = mn;
        }
        { const float mo = swap32(m, hi), lo = swap32(l, hi); const float mn = fmaxf(m, mo);
          l = l * __builtin_amdgcn_exp2f(m - mn) + lo * __builtin_amdgcn_exp2f(mo - mn); m = mn; }
        const float il = l > 0.f ? __builtin_amdgcn_rcpf(l) : 0.f;
        f32x16 o0, o1;
#pragma unroll
        for (int r = 0; r < 16; ++r) { o0[r] = 0.f; o1[r] = 0.f; }
        float carry = 0.f;
        LAS float* imp = IMP + ((sub * 4 + rr) * 32 + l31) * IMP_Q;
#pragma unroll 1
        for (int tile = 0; tile < 8; ++tile) {
            f32x16 s;
#pragma unroll
            for (int r = 0; r < 16; ++r) s[r] = 0.f;
            if (tile < ntile) {
                const LAS unsigned char* buf = F.lds + (tile >> 2) * CH_BYTES;
                s = qk_tile_lds(qf, buf, tile & 3, l31, hi);
#pragma unroll
                for (int r = 0; r < 16; ++r) { const int c = tile * 32 + (r & 3) + 8 * (r >> 2) + 4 * hi; s[r] = (c > cl) ? 0.f : __builtin_amdgcn_exp2f(s[r] - m) * il; }
                u32x4 p0, p1;
                p0.x = cvt_pk_bf16(s[0], s[1]); p0.y = cvt_pk_bf16(s[2], s[3]); p0.z = cvt_pk_bf16(s[4], s[5]); p0.w = cvt_pk_bf16(s[6], s[7]);
                p1.x = cvt_pk_bf16(s[8], s[9]); p1.y = cvt_pk_bf16(s[10], s[11]); p1.z = cvt_pk_bf16(s[12], s[13]); p1.w = cvt_pk_bf16(s[14], s[15]);
                pv_tile_lds(o0, o1, buf, tile & 3, l31, hi, __builtin_bit_cast(bf16x8, p0), __builtin_bit_cast(bf16x8, p1));
            }
            float rec[4], sum4[4];
#pragma unroll
            for (int k = 0; k < 4; ++k) { sum4[k] = (s[4 * k] + s[4 * k + 1]) + (s[4 * k + 2] + s[4 * k + 3]); rec[k] = swap32(s[4 * k + 3], hi); }
#pragma unroll
            for (int k = 0; k < 4; ++k) { const float add = hi ? rec[k] : (k == 0 ? carry : rec[k - 1]); imp[8 * tile + 2 * k + hi] = sum4[k] + add; }
            carry = rec[3];
        }
#pragma unroll
        for (int r = 0; r < 16; ++r) { out0[r] = g_c * o0[r]; out1[r] = g_c * o1[r]; }
    }
    __syncthreads();
    {
        const int q64 = F.wave * 8 + (lane >> 3), kk = lane & 7, qs = q64 >> 5, ql = q64 & 31, blkq = qt64;
        unsigned long long msk = 0ull;
        if (blkq < 16) { msk = (1ull << (blkq + 1)) - 1ull; }
        else {
            const LAS float* v0 = IMP + ((qs * 4 + 0) * 32 + ql) * IMP_Q; const LAS float* v1 = v0 + 32 * IMP_Q; const LAS float* v2 = v1 + 32 * IMP_Q; const LAS float* v3 = v2 + 32 * IMP_Q;
            float v[8];
#pragma unroll
            for (int i = 0; i < 8; ++i) { const int j = 8 * i + kk; float x = ((v0[j] + v1[j]) + v2[j]) + v3[j]; if (j == 0 || j == blkq || j == blkq - 1) x += 1e4f; v[i] = (j <= blkq) ? x : -INFINITY; }
#pragma unroll 1
            for (int it = 0; it < 16; ++it) {
                float bv = v[0]; int bj = kk;
#pragma unroll
                for (int i = 1; i < 8; ++i) { if (v[i] > bv) { bv = v[i]; bj = 8 * i + kk; } }
#define SELRED(ctrl) do { const float ov = DPP_F(bv, ctrl); const int oj = __builtin_amdgcn_update_dpp(0, bj, ctrl, 0xF, 0xF, true); if (ov > bv || (ov == bv && oj < bj)) { bv = ov; bj = oj; } } while (0)
                SELRED(0xB1); SELRED(0x4E); SELRED(0x141);
#undef SELRED
                msk |= 1ull << bj;
                const bool mine = (bj & 7) == kk; const int bi = bj >> 3;
#pragma unroll
                for (int i = 0; i < 8; ++i) { if (mine && i == bi) v[i] = -INFINITY; }
            }
        }
        if (kk == 0) { SELM[q64] = msk; __hip_atomic_fetch_or(UNI, (unsigned)msk, __ATOMIC_RELAXED, __HIP_MEMORY_SCOPE_WORKGROUP); __hip_atomic_fetch_or(UNI + 1, (unsigned)(msk >> 32), __ATOMIC_RELAXED, __HIP_MEMORY_SCOPE_WORKGROUP); }
    }
    __syncthreads();
    LAS f32x4* OUTP = (LAS f32x4*)(F.lds + NSA_IMP_OFF) + tid;
#pragma unroll
    for (int i = 0; i < 4; ++i) { OUTP[i * 512] = (f32x4){out0[4 * i], out0[4 * i + 1], out0[4 * i + 2], out0[4 * i + 3]}; OUTP[(4 + i) * 512] = (f32x4){out1[4 * i], out1[4 * i + 1], out1[4 * i + 2], out1[4 * i + 3]}; }
    {
        const unsigned long long selm = SELM[sub * 32 + l31];
        unsigned long long uni = ((unsigned long long)(unsigned)__builtin_amdgcn_readfirstlane((int)UNI[1]) << 32) | (unsigned long long)(unsigned)__builtin_amdgcn_readfirstlane((int)UNI[0]);
        const bf16_t* K = (const bf16_t*)(F.ws + WS_KS) + (size_t)bg * SEQ * 64;
        const bf16_t* VT = (const bf16_t*)(F.ws + WS_VST) + (size_t)bg * 64 * SEQ;
        AttnAcc A, A2; attn_init(A); attn_init(A2);
        int j0 = (int)__builtin_ctzll(uni); uni &= uni - 1ull;
        int j1 = uni ? (int)__builtin_ctzll(uni) : -1; if (uni) uni &= uni - 1ull;
        chunk_load(R, K, VT, SEQ, 64 * j0, 64 * (j1 < 0 ? j0 : j1), tid); chunk_store(R, F.lds, tid);
        __syncthreads();
        for (int c = 0;; ++c) {
            const LAS unsigned char* buf = F.lds + (c & 1) * CH_BYTES;
            int n0 = -1, n1 = -1;
            if (uni) { n0 = (int)__builtin_ctzll(uni); uni &= uni - 1ull; if (uni) { n1 = (int)__builtin_ctzll(uni); uni &= uni - 1ull; } }
            if (n0 >= 0) chunk_load(R, K, VT, SEQ, 64 * n0, 64 * (n1 < 0 ? n0 : n1), tid);
#pragma unroll
            for (int bp = 0; bp < 2; ++bp) {
                const int j = bp ? j1 : j0;
                if (j >= 0) {
                    const bool mine = (selm >> j) & 1ull;
                    unsigned vma = 0u, vmb = 0u;
                    if (mine) { const int d = t - 64 * j; vma = d >= 31 ? 0xffffffffu : (d < 0 ? 0u : ((2u << d) - 1u)); const int d2 = d - 32; vmb = d2 >= 31 ? 0xffffffffu : (d2 < 0 ? 0u : ((2u << d2) - 1u)); }
                    const bool ea = __ballot(vma != 0u) != 0ull, eb = __ballot(vmb != 0u) != 0ull;
                    if (ea && eb) attn_step_pair_lds(A, A2, qf, buf, 2 * bp, 2 * bp + 1, vma, vmb, l31, hi);
                    else if (ea) attn_step_lds(A, qf, buf, 2 * bp, vma, l31, hi);
                    else if (eb) attn_step_lds(A2, qf, buf, 2 * bp + 1, vmb, l31, hi);
                }
            }
            if (n0 >= 0) chunk_store(R, F.lds + ((c + 1) & 1) * CH_BYTES, tid);
            __syncthreads();
            if (n0 < 0) break;
            j0 = n0; j1 = n1;
        }
        attn_merge(A, A2);
        const float il = attn_inv_l(A) * g_s;
#pragma unroll
        for (int i = 0; i < 4; ++i) { f32x4 a = OUTP[i * 512], c2 = OUTP[(4 + i) * 512];
#pragma unroll
            for (int e = 0; e < 4; ++e) { a[e] += il * A.o0[4 * i + e]; c2[e] += il * A.o1[4 * i + e]; }
            OUTP[i * 512] = a; OUTP[(4 + i) * 512] = c2; }
    }
    {
        const bf16_t* K = (const bf16_t*)(F.ws + WS_KW) + (size_t)bg * SEQ * 64;
        const bf16_t* VT = (const bf16_t*)(F.ws + WS_VWT) + (size_t)bg * 64 * SEQ;
        AttnAcc A, A2; attn_init(A); attn_init(A2);
        const int T = 2 * qt64; int tile_lo = T - 16; if (tile_lo < 0) tile_lo = 0;
        const int kstart = tile_lo * 32, ntl = T + 2 - tile_lo, nch = (ntl + 3) >> 2;
        chunk_load(R, K, VT, SEQ, kstart, kstart + 64, tid); chunk_store(R, F.lds, tid);
        __syncthreads();
        for (int c = 0; c < nch; ++c) {
            const LAS unsigned char* buf = F.lds + (c & 1) * CH_BYTES;
            if (c + 1 < nch) chunk_load(R, K, VT, SEQ, kstart + 128 * (c + 1), kstart + 128 * (c + 1) + 64, tid);
#pragma unroll
            for (int tp = 0; tp < 2; ++tp) {
                unsigned vmp[2];
#pragma unroll
                for (int e = 0; e < 2; ++e) { const int key0 = kstart + 128 * c + 32 * (2 * tp + e);
                    const int dhi = t - key0, dlo = t - 511 - key0;
                    unsigned vm = dhi >= 31 ? 0xffffffffu : (dhi < 0 ? 0u : ((2u << dhi) - 1u));
                    if (dlo > 0) vm &= (dlo >= 32 ? 0u : ~((1u << dlo) - 1u));
                    vmp[e] = vm; }
                const bool ea = __ballot(vmp[0] != 0u) != 0ull, eb = __ballot(vmp[1] != 0u) != 0ull;
                if (ea && eb) attn_step_pair_lds(A, A2, qf, buf, 2 * tp, 2 * tp + 1, vmp[0], vmp[1], l31, hi);
                else if (ea) attn_step_lds(A, qf, buf, 2 * tp, vmp[0], l31, hi);
                else if (eb) attn_step_lds(A2, qf, buf, 2 * tp + 1, vmp[1], l31, hi);
            }
            if (c + 1 < nch) chunk_store(R, F.lds + ((c + 1) & 1) * CH_BYTES, tid);
            __syncthreads();
        }
        attn_merge(A, A2);
        const float il = attn_inv_l(A) * g_w;
#pragma unroll
        for (int i = 0; i < 4; ++i) { const f32x4 a = OUTP[i * 512], c2 = OUTP[(4 + i) * 512];
#pragma unroll
            for (int e = 0; e < 4; ++e) { out0[4 * i + e] = a[e] + il * A.o0[4 * i + e]; out1[4 * i + e] = c2[e] + il * A.o1[4 * i + e]; } }
    }
    attn_store(out0, out1, ybase + ((size_t)b * SEQ + t) * 512 + head * 64, hi);
    __syncthreads();
}

#ifndef DBG_PROBE
#define DBG_PROBE 0
#endif
#ifndef DBG_TS
#define DBG_TS -1
#endif
#ifndef DBG_DUP
#define DBG_DUP -1
#endif
#define REPS(k) for (int rep = 0; rep < ((DBG_DUP == (k)) ? 2 : 1); ++rep)
#define REPBAR() do { if (rep == 0 && DBG_DUP >= 0) xcd_barrier(bar); } while (0)

__device__ __forceinline__ void naive_ffn1_row(Frame& F, const float* out) {
    LAS float* u = (LAS float*)F.lds; LAS float* h = u + 1024;
    LAS float* red = h + 2816;
    const int row = F.blk * 128 + 77;
    const float* x = (DBG_PROBE == 9 ? (const float*)(F.ws + WS_XR) : INP(0)) + (size_t)row * DM; const float* mod = (const float*)(F.ws + WS_MOD) + (size_t)(row >> 12) * NMOD + (DBG_PROBE == 9 ? 6 * DM : 0);
    for (int k = F.tid; k < DM; k += NTHREADS) u[k] = x[k] * (1.0f + mod[DM + k]) + mod[k];
    __syncthreads();
    const float* win = INP(DBG_PROBE == 9 ? 22 : 4); const float* wout = INP(DBG_PROBE == 9 ? 23 : 5);
    for (int j = F.tid; j < DFF; j += NTHREADS) { float a = 0.f, b = 0.f;
        for (int k = 0; k < DM; ++k) { a += u[k] * win[(size_t)k * NFF + j]; b += u[k] * win[(size_t)k * NFF + DFF + j]; }
        h[j] = (a / (1.0f + __expf(-a))) * b; }
    __syncthreads();
    float sd = 0.f, sr = 0.f;
    for (int n = F.tid; n < DM; n += NTHREADS) { float f = 0.f;
        for (int k = 0; k < DFF; ++k) f += h[k] * wout[(size_t)k * DM + n];
        const float term = 0.5f * mod[2 * DM + n] * f; const float fast = out[(size_t)row * DM + n] - ALPHA * x[n];
        sd += fabsf(fast - term); sr += fabsf(term); }
    sd = wave_sum(sd); sr = wave_sum(sr);
    if (F.lane == 0) { red[F.wave] = sd; red[8 + F.wave] = sr; }
    __syncthreads();
    if (F.tid == 0) { float a = 0.f, b = 0.f; for (int w = 0; w < 8; ++w) { a += red[w]; b += red[8 + w]; }
        float* slot = (float*)(F.ws + WS_CTL + 32768); slot[2 * F.blk] = a; slot[2 * F.blk + 1] = b; }
}
__device__ __forceinline__ void probe_stage(Frame& F, float* out, const XcdBarrier& bar) {
    if (DBG_PROBE == 8 || DBG_PROBE == 9) { naive_ffn1_row(F, out); xcd_barrier(bar); }
    if (DBG_PROBE == 11) {
        LAS float* red = (LAS float*)F.lds; float sd = 0.f, sr = 0.f;
        const int row = F.blk * 128 + 77; const float* y = out + (size_t)row * DM; const float* mod = (const float*)(F.ws + WS_MOD) + (size_t)(row >> 12) * NMOD;
        float mean = 0.f; for (int k = 0; k < DM; ++k) mean += y[k]; mean /= DM;
        float var = 0.f; for (int k = 0; k < DM; ++k) { const float d = y[k] - mean; var += d * d; } var /= DM;
        const float rstd = 1.0f / sqrtf(var + LN_EPS);
        for (int n = F.tid; n < DM; n += NTHREADS) { const float xn = (y[n] - mean) * rstd * INP(6)[n] + INP(7)[n];
            const float un = xn * (1.0f + mod[4 * DM + n]) + mod[3 * DM + n];
            sd += fabsf(xn - ((const float*)(F.ws + WS_XR))[(size_t)row * DM + n]) + fabsf(un - bf2f(((const bf16_t*)(F.ws + WS_U))[(size_t)row * DM + n])); sr += fabsf(xn) + fabsf(un); }
        sd = wave_sum(sd); sr = wave_sum(sr);
        if (F.lane == 0) { red[F.wave] = sd; red[8 + F.wave] = sr; }
        __syncthreads();
        if (F.tid == 0) { float a = 0.f, b2 = 0.f; for (int w = 0; w < 8; ++w) { a += red[w]; b2 += red[8 + w]; }
            float* slot = (float*)(F.ws + WS_CTL + 32768); slot[2 * F.blk] = a; slot[2 * F.blk + 1] = b2; }
        xcd_barrier(bar);
    }
    if (DBG_PROBE == 10) {
        LAS float* red = (LAS float*)F.lds; float sd = 0.f, sr = 0.f;
        if (F.tid < 288) { const int b = F.tid / 36, n = 36 * F.blk + F.tid % 36; float acc = INP(3)[n];
            for (int k = 0; k < DM; ++k) { const float c = INP(1)[b * DM + k]; acc += (c / (1.0f + __expf(-c))) * INP(2)[(size_t)k * NMOD + n]; }
            const float m = ((const float*)(F.ws + WS_MOD))[(size_t)b * NMOD + n]; sd = fabsf(m - acc); sr = fabsf(acc); }
        sd = wave_sum(sd); sr = wave_sum(sr);
        if (F.lane == 0) { red[F.wave] = sd; red[8 + F.wave] = sr; }
        __syncthreads();
        if (F.tid == 0) { float a = 0.f, b2 = 0.f; for (int w = 0; w < 8; ++w) { a += red[w]; b2 += red[8 + w]; }
            float* slot = (float*)(F.ws + WS_CTL + 32768); slot[2 * F.blk] = a; slot[2 * F.blk + 1] = b2; }
        xcd_barrier(bar);
    }
    float val = 0.f;
    if (F.blk == 0) {
        float acc = 0.f; const int N = 1 << 18;
        for (int i = F.tid; i < N; i += NTHREADS) {
            float v = 0.f;
            if (DBG_PROBE == 1) v = ((const float*)(F.ws + WS_MOD))[i % (8 * NMOD)];
            if (DBG_PROBE == 2) v = bf2f(((const bf16_t*)(F.ws + WS_W1IN))[i]);
            if (DBG_PROBE == 3) v = bf2f(((const bf16_t*)(F.ws + WS_HF))[i]);
            if (DBG_PROBE == 4) v = bf2f(((const bf16_t*)(F.ws + WS_U))[i]);
            if (DBG_PROBE == 5) v = ((const float*)(F.ws + WS_XR))[i];
            if (DBG_PROBE == 6) v = bf2f(((const bf16_t*)(F.ws + WS_W1OUT))[i]);
            if (DBG_PROBE == 7) v = out[i] - ALPHA * INP(0)[i];
            acc += fabsf(v);
        }
        acc = wave_sum(acc);
        LAS float* red = (LAS float*)F.lds;
        if (F.lane == 0) red[F.wave] = acc;
        __syncthreads();
        float s = 0.f; for (int w = 0; w < NWAVES; ++w) s += red[w];
        val = 1000.0f * s / (float)N;
        if (DBG_TS >= 0) { const unsigned long long* ts = (const unsigned long long*)(F.ws + WS_CTL + 40960); val = 0.01f * (float)(ts[DBG_TS + 1] - ts[DBG_TS]); }
        if (DBG_PROBE >= 8) { const float* slot = (const float*)(F.ws + WS_CTL + 32768); float a = 0.f, b = 0.f; for (int i = 0; i < 256; ++i) { a += slot[2 * i]; b += slot[2 * i + 1]; } val = 100000.0f * a / b; }
    }
    xcd_barrier(bar);
    for (size_t i = (size_t)F.blk * NTHREADS + F.tid; i < (size_t)MROWS * DM / 4; i += (size_t)F.G * NTHREADS) ((f32x4*)out)[i] = (f32x4){i == 0 ? val : 0.f, 0.f, 0.f, 0.f};
}

__global__ void __launch_bounds__(NTHREADS, 2) mk_fwd(Args args) {
    extern __shared__ __attribute__((aligned(16))) unsigned char lds_raw[];
    cg::grid_group grid = cg::this_grid();
    Frame F;
    F.lds = (LAS unsigned char*)lds_raw; F.in = args.in;
    LAS int* qword = (LAS int*)(F.lds + LDS_BYTES - 16);
    volatile LAS unsigned* bst = (volatile LAS unsigned*)(F.lds + LDS_BYTES - 32);
    if (threadIdx.x < 8) ((LAS unsigned*)(F.lds + LDS_BYTES - 32))[threadIdx.x] = 0u;
    __syncthreads();
    XcdBarrier bar = xcd_barrier_post((unsigned*)(args.ws + WS_CTL) + CW_BAR, bst);

    const int lo = args.ph_lo, hi = args.ph_hi;
    unsigned char* ws_ = args.ws; float* out_ = args.out; int tid_ = threadIdx.x;
#define RELAUNDER() do { ws_ = launder_ptr(ws_); out_ = launder_ptr(out_); asm volatile("" : "+v"(tid_)); \
        { int b_ = blockIdx.x, g_ = gridDim.x; asm volatile("" : "+v"(b_), "+v"(g_)); F.blk = __builtin_amdgcn_readfirstlane(b_); F.G = __builtin_amdgcn_readfirstlane(g_); } \
        F.ws = ws_; F.dout = (unsigned char*)out_; F.tid = tid_; F.lane = tid_ & 63; F.wave = __builtin_amdgcn_readfirstlane(tid_ >> 6); } while (0)
#define IN(k) (lo <= (k) && (k) < hi && STG(k))
#define SYNC(k) do { if (lo <= (k) && (k) + 1 < hi) { if ((k) == 9 && DBG_DUP < 0) { asm volatile("s_waitcnt vmcnt(0)" ::: "memory"); __syncthreads(); } else xcd_barrier(bar); } if (DBG_TS >= 0 && blockIdx.x == 0 && threadIdx.x == 0) ((unsigned long long*)(args.ws + WS_CTL + 40960))[(k) + 1] = __builtin_amdgcn_s_memrealtime(); } while (0)
#define MODP ((const float*)(F.ws + WS_MOD))
#define UBUF ((bf16_t*)(F.ws + WS_U))
#define STATBUF ((f32x2*)(F.ws + WS_XR))
#define YBUF ((bf16_t*)(F.ws + WS_XR + 64 * MiB))
#define HFBUF ((bf16_t*)(F.ws + WS_HF))
#define GW (F.blk * NWAVES + F.wave)
#define NGW (F.G * NWAVES)
    if (DBG_TS >= 0 && blockIdx.x == 0 && threadIdx.x == 0) ((unsigned long long*)(args.ws + WS_CTL + 40960))[0] = __builtin_amdgcn_s_memrealtime();
    if (IN(0)) REPS(0) { RELAUNDER(); stage_prologue(F, args);  REPBAR(); }
    SYNC(0);
    if (IN(1)) REPS(1) { RELAUNDER(); stage_mod_u1(F);  REPBAR(); }
    SYNC(1);
    if (IN(2)) REPS(2) { RELAUNDER();
        pg8::Gemm g{UBUF, (const bf16_t*)(F.ws + WS_W1IN), MROWS, NFF, DM, DM}; pg8::StaticOrder S; S.init(MROWS, NFF, F.G, F.blk);
        EpiSwiglu E{HFBUF}; pg8::gemm_phase(F.lds, g, S, E); REPBAR(); }
    SYNC(2);
    if (IN(3)) REPS(3) { RELAUNDER();
        pg8::Gemm g{HFBUF, (const bf16_t*)(F.ws + WS_W1OUT), MROWS, DM, DFF, DFF}; pg8::StaticOrder S; S.init(MROWS, DM, F.G, F.blk);
        EpiResid<true> E{INP(0), MODP + 2 * DM, YBUF, nullptr, nullptr, nullptr, FFN1_COEF, 0}; pg8::gemm_phase(F.lds, g, S, E); REPBAR(); }
    SYNC(3);
    if (IN(4)) REPS(4) { RELAUNDER(); stage_rows<1>(F, YBUF, nullptr, STATBUF, UBUF, INP(6), INP(7), MODP + 3 * DM, MODP + 4 * DM);  REPBAR(); }
    SYNC(4);
#if !DBG_SKIP_MIXER
    if (IN(5)) REPS(5) { RELAUNDER();
        pg8::Gemm g{UBUF, (const bf16_t*)(F.ws + WS_WMIX), MROWS, NMIX, DM, DM}; pg8::StaticOrder S; S.init(MROWS, NMIX, F.G, F.blk);
        EpiMix E{F.ws, F.dout}; pg8::gemm_phase(F.lds, g, S, E);
        if (rep == 0 && F.blk >= 128) { RELAUNDER(); ffn2_transposes(F, args, (F.blk - 128) * NWAVES + F.wave, 128 * NWAVES); }
        REPBAR(); }
    SYNC(5);
    if (IN(6)) REPS(6) {
        RELAUNDER();
        { const int kv = F.blk >> 4;
          pg8::Gemm g{(const bf16_t*)(F.ws + (kv ? WS_VC : WS_KC)), (const bf16_t*)(F.ws + (kv ? WS_WC1V : WS_WC1K)), 4096, 256, 2048, 1024};
          pg8::StaticOrder S; S.init(4096, 256, F.G, F.blk < 32 ? (F.blk & 15) : -1);
          EpiCmp1 E{F.ws, kv}; pg8::gemm_phase(F.lds, g, S, E); }
        RELAUNDER();
        for (int it = GW; it < MROWS / 32; it += NGW) kvup_item(F, it);
        __syncthreads();
        RELAUNDER();
        if (rep == 0 || (EXP6 & 1)) {
            const int grp = F.wave >> 2, gw = F.wave & 3;
            LAS unsigned* Srows = (LAS unsigned*)F.lds + grp * 4 * SEL_ROW;
            LAS unsigned* ctl = (LAS unsigned*)F.lds + 8 * SEL_ROW;
            if (F.tid < 4) ctl[F.tid] = 0u;
            __syncthreads();
            unsigned* tick = (unsigned*)(F.ws + WS_CTL) + CW_QSEL + 16 * rep;
            const bool lead = (gw == 0 && F.lane == 0);
            unsigned target = 0u; int unext = 0;
            if (lead) unext = (int)atomicAdd(tick, 1u);
            for (;;) {
                if (lead) ctl[2 + grp] = (unsigned)unext;
                sel_gbar(ctl + grp, target, F.lane);
                const int u = __builtin_amdgcn_readfirstlane((int)__hip_atomic_load(ctl + 2 + grp, __ATOMIC_RELAXED, __HIP_MEMORY_SCOPE_WORKGROUP));
                if (u >= NB * 1024) break;
                if (lead) unext = (int)atomicAdd(tick, 1u);
                const int b = u & 7, t0 = (1023 - (u >> 3)) * 4;
                sel_scores4(F, Srows, gw, b, t0);
                sel_gbar(ctl + grp, target, F.lane);
                sel_radix(F, Srows + gw * SEL_ROW, b, t0 + gw, rep);
            }
            __syncthreads();
        }
        REPBAR();
    }
    SYNC(6);
    if (IN(7)) REPS(7) {
        RELAUNDER();
        unsigned* c2done = (unsigned*)(F.ws + WS_CTL) + CW_C2 + 16 * rep;
        for (int it = GW; it < 256; it += NGW) { cmp2_item(F, it);
            __builtin_amdgcn_fence(__ATOMIC_RELEASE, "agent");
            if (F.lane == 0) __hip_atomic_fetch_add(c2done, 1u, __ATOMIC_RELAXED, __HIP_MEMORY_SCOPE_AGENT); }
        RELAUNDER();
        for (;;) { if (F.tid == 0) *qword = (int)atomicAdd((unsigned*)(F.ws + WS_CTL) + CW_QDSA + 16 * rep, 1u); __syncthreads(); const int u = *qword; __syncthreads(); if (u >= NB * 64) break;
            dsa_attn_unit(F, u & 7, 63 - (u >> 3), rep ? (bf16_t*)(F.dout + 96 * MiB) : (bf16_t*)(F.ws + WS_QA)); }
        RELAUNDER();
        if (F.tid == 0) { while (__hip_atomic_load(c2done, __ATOMIC_RELAXED, __HIP_MEMORY_SCOPE_AGENT) < 256u) __builtin_amdgcn_s_sleep(4);
            __builtin_amdgcn_fence(__ATOMIC_ACQUIRE, "agent"); }
        __syncthreads();
        for (;;) { if (F.tid == 0) *qword = (int)atomicAdd((unsigned*)(F.ws + WS_CTL) + CW_QNSA + 16 * rep, 1u); __syncthreads(); const int u = *qword; __syncthreads(); if (u >= NB * 2 * 64) break;
            nsa_unit(F, (u & 15) >> 1, u & 1, 63 - (u >> 4), rep ? (bf16_t*)(F.dout + 96 * MiB) : (bf16_t*)(F.dout + DO_QB)); }
        REPBAR();
    }
    SYNC(7);
    if (IN(9)) REPS(9) { RELAUNDER();
        pg8::Gemm g{(const bf16_t*)(F.ws + WS_QA), (const bf16_t*)(F.ws + WS_WBRA), MROWS, DM, 512, 512}; pg8::StaticOrder S; S.init(MROWS, DM, F.G, F.blk);
        EpiGate E{(const bf16_t*)(F.ws + WS_GATE), 0, nullptr, (bf16_t*)(F.dout + DO_T)}; pg8::gemm_phase(F.lds, g, S, E); REPBAR(); }
    SYNC(9);
    if (IN(10)) REPS(10) { RELAUNDER();
        pg8::Gemm g{(const bf16_t*)(F.dout + DO_QB), (const bf16_t*)(F.ws + WS_WBRB), MROWS, DM, 512, 512}; pg8::StaticOrder S; S.init(MROWS, DM, F.G, F.blk);
        EpiGate E{(const bf16_t*)(F.ws + WS_GATE), 1024, (const bf16_t*)(F.dout + DO_T), UBUF}; pg8::gemm_phase(F.lds, g, S, E); REPBAR(); }
    SYNC(10);
    if (IN(11)) REPS(11) { RELAUNDER();
        pg8::Gemm g{UBUF, (const bf16_t*)(F.ws + WS_WMO), MROWS, DM, DM, DM}; pg8::StaticOrder S; S.init(MROWS, DM, F.G, F.blk);
        EpiResid<false> E{nullptr, MODP + 5 * DM, YBUF, STATBUF, INP(6), INP(7), 1.0f, 0}; pg8::gemm_phase(F.lds, g, S, E); REPBAR(); }
    SYNC(11);
#else
    SYNC(5); SYNC(6); SYNC(7); SYNC(8); SYNC(9); SYNC(10);
    if (IN(11)) REPS(11) { RELAUNDER();
        for (size_t i = (size_t)F.blk * NTHREADS + F.tid; i < (size_t)MROWS * DM / 4; i += (size_t)F.G * NTHREADS) ((f32x4*)out_)[i] = ((const f32x4*)XRBUF)[i] * ALPHA; REPBAR(); }
    SYNC(11);
#endif
    if (IN(12)) REPS(12) { RELAUNDER(); stage_rows<1>(F, YBUF, nullptr, STATBUF, UBUF, INP(20), INP(21), MODP + 6 * DM, MODP + 7 * DM);  REPBAR(); }
    SYNC(12);
    if (IN(13)) REPS(13) { RELAUNDER();
        pg8::Gemm g{UBUF, (const bf16_t*)(F.ws + WS_W2IN), MROWS, NFF, DM, DM}; pg8::StaticOrder S; S.init(MROWS, NFF, F.G, F.blk);
        EpiSwiglu E{HFBUF}; pg8::gemm_phase(F.lds, g, S, E); REPBAR(); }
    SYNC(13);
    if (IN(14)) REPS(14) { RELAUNDER();
        pg8::Gemm g{HFBUF, (const bf16_t*)(F.ws + WS_W2OUT), MROWS, DM, DFF, DFF}; pg8::StaticOrder S; S.init(MROWS, DM, F.G, F.blk);
        EpiResid<false> E{nullptr, MODP + 8 * DM, YBUF, STATBUF, INP(20), INP(21), FFN2_COEF, 0}; pg8::gemm_phase(F.lds, g, S, E); REPBAR(); }
    SYNC(14);
    if (IN(15)) REPS(15) { RELAUNDER(); stage_rows<2>(F, YBUF, out_, nullptr, nullptr, INP(24), INP(25), nullptr, nullptr);  REPBAR(); }
    SYNC(15);
    if (DBG_PROBE || DBG_TS >= 0) { xcd_barrier(bar); RELAUNDER(); probe_stage(F, out_, bar); }
}

extern "C" void kernel_launch(void* const* d_in, const int* in_sizes, int n_in, void* d_out, int out_size, void* d_ws, size_t ws_size, hipStream_t stream) {
    static int grid = 0;
    if (grid == 0) {
        if (n_in != 26 || out_size != MROWS * DM || ws_size < WS_END) { fprintf(stderr, "kernel_launch: unexpected shapes (n_in %d out %d ws %zu)\n", n_in, out_size, ws_size); grid = -1; return; }
        if (hipFuncSetAttribute((const void*)mk_fwd, hipFuncAttributeMaxDynamicSharedMemorySize, LDS_BYTES) != hipSuccess) { fprintf(stderr, "kernel_launch: hipFuncSetAttribute failed\n"); grid = -1; return; }
        int dev = 0, cus = 0, per_cu = 0;
        hipGetDevice(&dev); hipDeviceGetAttribute(&cus, hipDeviceAttributeMultiprocessorCount, dev);
        hipOccupancyMaxActiveBlocksPerMultiprocessor(&per_cu, (const void*)mk_fwd, NTHREADS, LDS_BYTES);
        (void)hipGetLastError();
        if (per_cu < 1 || cus != 256) fprintf(stderr, "kernel_launch: note: occupancy %d blocks/CU, %d CUs\n", per_cu, cus);
        grid = 256;
    }
    if (grid < 0) return;
    hipMemsetAsync((char*)d_ws + WS_CTL, 0, CTL_ZERO_BYTES, stream);
    Args a{};
    for (int i = 0; i < 26; ++i) a.in[i] = (const float*)d_in[i];
    a.out = (float*)d_out; a.ws = (unsigned char*)d_ws;
    for (int d = 0; d < 32; ++d) a.inv_freq[d] = powf(10000.0f, -(float)d / 32.0f);
    a.ph_lo = STAGE_LO; a.ph_hi = STAGE_HI;
    void* kargs[] = {&a};
    hipError_t e = hipLaunchCooperativeKernel((const void*)mk_fwd, dim3(grid), dim3(NTHREADS), kargs, LDS_BYTES, stream);
    if (e != hipSuccess) fprintf(stderr, "kernel_launch: cooperative launch failed: %s\n", hipGetErrorString(e));
}
```

```cpp
#include <hip/hip_runtime.h>
#include <hip/hip_cooperative_groups.h>
#include <cstdio>
#include <cmath>
namespace cg = cooperative_groups;

#define GAS __attribute__((address_space(1)))
#define LAS __attribute__((address_space(3)))
typedef unsigned short bf16_t;
typedef short bf16x8 __attribute__((ext_vector_type(8)));
typedef short s16x4 __attribute__((ext_vector_type(4)));
typedef _Float16 f16x8 __attribute__((ext_vector_type(8)));
typedef float f32x2 __attribute__((ext_vector_type(2)));
typedef float f32x4 __attribute__((ext_vector_type(4)));
typedef float f32x16 __attribute__((ext_vector_type(16)));
typedef unsigned u32x2 __attribute__((ext_vector_type(2)));
typedef unsigned u32x4 __attribute__((ext_vector_type(4)));
typedef GAS unsigned gu32;

#ifndef EXP6
#define EXP6 0
#endif
#ifndef STAGE_LO
#define STAGE_LO 0
#endif
#ifndef STAGE_HI
#define STAGE_HI 16
#endif
#ifndef ONLY
#define ONLY -1
#endif
#define STG(n) (ONLY < 0 || ONLY == (n))
#ifndef FFN1_COEF
#define FFN1_COEF 0.5f
#endif
#ifndef FFN2_COEF
#define FFN2_COEF 0.5f
#endif
#ifndef DBG_NO_FFN
#define DBG_NO_FFN 0
#endif
#ifndef DBG_SKIP_MIXER
#define DBG_SKIP_MIXER 0
#endif

constexpr int NB = 8, SEQ = 4096, DM = 1024, MROWS = NB * SEQ, DFF = 2816, NFF = 2 * DFF, NMIX = 4352, NMOD = 9 * DM;
constexpr float ALPHA = 1.189207115002721f;
constexpr float LN_EPS = 1e-5f;
constexpr float QSCALE = 0.125f * 1.4426950408889634f;
constexpr int NWAVES = 8, NTHREADS = 512;
constexpr int LDS_BYTES = 163840;

constexpr size_t MiB = 1u << 20;
constexpr size_t WS_CTL = 0, CTL_ZERO_BYTES = 65536;
constexpr size_t WS_MODP = 1 * MiB;
constexpr size_t WS_MOD = 3 * MiB + 512 * 1024;
constexpr size_t WS_ROPE = 4 * MiB;
constexpr size_t WS_BIAS1P = 5 * MiB;
constexpr size_t WS_WKVUP = 5 * MiB + 64 * 1024;
constexpr size_t WS_WC2K = 5 * MiB + 128 * 1024;
constexpr size_t WS_WC2V = 5 * MiB + 192 * 1024;
constexpr size_t WS_W1IN = 6 * MiB, WS_W1OUT = 17 * MiB, WS_W2IN = 23 * MiB, WS_W2OUT = 34 * MiB, WS_WMIX = 40 * MiB;
constexpr size_t WS_WBRA = 49 * MiB, WS_WBRB = 50 * MiB, WS_WMO = 51 * MiB, WS_WC1K = 53 * MiB, WS_WC1V = 54 * MiB;
constexpr size_t WS_U = 56 * MiB;
constexpr size_t WS_XR = 120 * MiB;
constexpr size_t WS_HF = 248 * MiB;
constexpr size_t WS_GATE = 248 * MiB, WS_QA = 376 * MiB, WS_QI = 408 * MiB;
constexpr size_t WS_MASK = 424 * MiB;
constexpr size_t WS_KC = 440 * MiB, WS_VC = 448 * MiB, WS_KS = 456 * MiB, WS_VST = 464 * MiB, WS_KW = 472 * MiB, WS_VWT = 480 * MiB;
constexpr size_t WS_HIDK = 488 * MiB, WS_HIDV = 490 * MiB, WS_KI = 492 * MiB, WS_KA = 496 * MiB, WS_VAT = 500 * MiB, WS_KVL = 504 * MiB;
constexpr size_t WS_END = 512 * MiB;
constexpr size_t DO_QB = 0, DO_GB = 32 * MiB, DO_WI = 35 * MiB, DO_KCMP = 36 * MiB, DO_VCMPT = 37 * MiB, DO_T = 64 * MiB;
constexpr int CW_QSEL = 64, CW_QDSA = 128, CW_QNSA = 192, CW_C2 = 256, CW_BAR = 4096;

struct Args { const float* in[26]; float* out; unsigned char* ws; float inv_freq[32]; int ph_lo, ph_hi; };

__device__ __forceinline__ unsigned cvt_pk_bf16(float lo, float hi) { unsigned r; asm volatile("v_cvt_pk_bf16_f32 %0, %1, %2" : "=v"(r) : "v"(lo), "v"(hi)); return r; }
__device__ __forceinline__ unsigned cvt_pk_f16(float lo, float hi) { typedef _Float16 h2 __attribute__((ext_vector_type(2))); h2 v; v.x = (_Float16)lo; v.y = (_Float16)hi; return __builtin_bit_cast(unsigned, v); }
__device__ __forceinline__ float bf2f(unsigned short b) { return __uint_as_float(((unsigned)b) << 16); }
__device__ __forceinline__ float sigmoidf_(float x) { return __builtin_amdgcn_rcpf(1.0f + __builtin_amdgcn_exp2f(-1.4426950408889634f * x)); }
__device__ __forceinline__ float siluf_(float x) { return x * __builtin_amdgcn_rcpf(1.0f + __builtin_amdgcn_exp2f(-1.4426950408889634f * x)); }
#define DPP_F(v, ctrl) __int_as_float(__builtin_amdgcn_update_dpp(0, __float_as_int(v), (ctrl), 0xF, 0xF, true))
__device__ __forceinline__ float dpp_xor1(float v) { return DPP_F(v, 0xB1); }
__device__ __forceinline__ float dpp_xor2(float v) { return DPP_F(v, 0x4E); }
__device__ __forceinline__ float swap32(float v, int hi) { const auto rr = __builtin_amdgcn_permlane32_swap(__float_as_uint(v), __float_as_uint(v), false, false); return __uint_as_float(hi ? rr[0] : rr[1]); }
__device__ __forceinline__ float max32(float v) { const auto rr = __builtin_amdgcn_permlane32_swap(__float_as_uint(v), __float_as_uint(v), false, false); return fmaxf(__uint_as_float(rr[0]), __uint_as_float(rr[1])); }
__device__ __forceinline__ float sum32(float v) { const auto rr = __builtin_amdgcn_permlane32_swap(__float_as_uint(v), __float_as_uint(v), false, false); return __uint_as_float(rr[0]) + __uint_as_float(rr[1]); }
__device__ __forceinline__ float wave_sum(float v) {
    v += dpp_xor1(v); v += dpp_xor2(v); v += DPP_F(v, 0x141); v += DPP_F(v, 0x140);
    { const auto rr = __builtin_amdgcn_permlane16_swap(__float_as_uint(v), __float_as_uint(v), false, false); v = __uint_as_float(rr[0]) + __uint_as_float(rr[1]); }
    return sum32(v);
}
#define LDS_WAIT() asm volatile("s_waitcnt lgkmcnt(0)" ::: "memory")
template <class T> __device__ __forceinline__ T* launder_ptr(T* p) {
    unsigned lo = (unsigned)(unsigned long long)p, hi = (unsigned)((unsigned long long)p >> 32);
    asm volatile("" : "+v"(lo), "+v"(hi));
    lo = (unsigned)__builtin_amdgcn_readfirstlane((int)lo); hi = (unsigned)__builtin_amdgcn_readfirstlane((int)hi);
    return (T*)(GAS T*)(((unsigned long long)hi << 32) | (unsigned long long)lo);
}

namespace pg8 {
#define PG8_LAS __attribute__((address_space(3)))
constexpr int BM = 256, BK = 64, HALF = 128, HTB = HALF * BK * 2, STAGE_BYTES = 8 * HTB, NXCD = 8, WGM = 8;
__host__ __device__ __forceinline__ int lds_byte(int r, int c) { const int st = (r >> 4) * 2 + (c >> 5), rr = r & 15, cc = c & 31, ob = rr * 64 + cc * 2; return st * 1024 + (ob ^ (((ob >> 9) & 1) << 5)); }
__host__ __device__ __forceinline__ void stage_rc(int b, int& R, int& C) { const int st = b / 1024, sb = b % 1024, swz = sb ^ (((sb >> 9) & 1) << 5); R = (st >> 1) * 16 + swz / 64; C = (st & 1) * 32 + (swz % 64) / 2; }
__host__ __device__ __forceinline__ int perm32(int rho) { const int n = rho >> 4, i = rho & 15; return 8 * (i >> 2) + 4 * n + (i & 3); }
struct Unit { int pm, pn; };
struct Gemm { const bf16_t* A; const bf16_t* Bt; int M, N, K, lda; };
struct StaticOrder {
    int nM, nN, nwg, G, c;
    __host__ __device__ void init(int M, int N, int G_, int c_) { nM = M / BM; nN = N / BM; nwg = nM * nN; G = G_; c = c_; }
    __host__ __device__ bool next(int i, Unit& u) const {
        if (c < 0) return false;
        const long L = (long)i * G + c; if (L >= nwg) return false;
        int wgid = (int)L; { const int q = nwg / NXCD, r = nwg % NXCD, xcd = wgid % NXCD, off = wgid / NXCD; wgid = (xcd < r ? xcd * (q + 1) : r * (q + 1) + (xcd - r) * q) + off; }
        const int nig = WGM * nN, gid = wgid / nig, fm = gid * WGM, gsz = (nM - fm) < WGM ? (nM - fm) : WGM;
        u.pm = fm + ((wgid % nig) % gsz); u.pn = (wgid % nig) / gsz; return true;
    }
};
template <class Epi, class Sched>
__device__ __forceinline__ void gemm_phase(PG8_LAS unsigned char* lds, const Gemm g, const Sched& S, const Epi& E) {
    int tid = threadIdx.x; asm volatile("" : "+v"(tid));
    const int wid = __builtin_amdgcn_readfirstlane(tid >> 6), lane = tid & 63, wr = wid >> 2, wc = wid & 3, fr = lane & 15, fq = lane >> 4;
    const int K = g.K, nt = K / BK, lda = g.lda;
    unsigned voffA[2], voffB[2];
#pragma unroll
    for (int i = 0; i < 2; ++i) { int R, C; stage_rc(tid * 16 + i * 8192, R, C); const int Rb = Epi::PERM ? ((R & ~31) + perm32(R & 31)) : R;
        voffA[i] = (unsigned)(R * lda + C) * 2u; voffB[i] = (unsigned)(Rb * K + C) * 2u; }
    const size_t kstep = (size_t)(BK * 2);
    const size_t hstepA = (size_t)HALF * lda * 2, hstepB = (size_t)HALF * K * 2;
    const size_t tstepA = 2 * hstepA, tstepB = 2 * hstepB;
    const unsigned ldsw = (unsigned)wid * 1024u;
    const int aoff = lds_byte(wr * 64 + fr, fq * 8), boff = lds_byte(wc * 32 + fr, fq * 8);
#define PG8_SA(b, h) (((b) * 2 + (h)) * HTB)
#define PG8_SB(b, h) ((4 + (b) * 2 + (h)) * HTB)
#define PG8_STAGE(bufoff, gbase, voff) do { _Pragma("unroll") for (int _i = 0; _i < 2; ++_i) \
        __builtin_amdgcn_global_load_lds((const unsigned*)((const char*)(gbase) + (voff)[_i]), (PG8_LAS unsigned*)(lds + (bufoff) + ldsw + _i * 8192), 16, 0, 0); } while (0)
#define PG8_LDA(dst, b, h) do { _Pragma("unroll") for (int m = 0; m < 4; ++m) _Pragma("unroll") for (int k = 0; k < 2; ++k) dst[m][k] = *(const PG8_LAS bf16x8*)(lds + PG8_SA(b, h) + aoff + m * 2048 + k * 1024); } while (0)
#define PG8_LDB(dst, b, h) do { _Pragma("unroll") for (int n = 0; n < 2; ++n) _Pragma("unroll") for (int k = 0; k < 2; ++k) dst[n][k] = *(const PG8_LAS bf16x8*)(lds + PG8_SB(b, h) + boff + n * 2048 + k * 1024); } while (0)
#define PG8_MMA(ai, bj, At, Bt) do { __builtin_amdgcn_s_setprio(1); _Pragma("unroll") for (int m = 0; m < 4; ++m) _Pragma("unroll") for (int n = 0; n < 2; ++n) _Pragma("unroll") for (int k = 0; k < 2; ++k) \
        acc[ai][bj][m][n] = __builtin_amdgcn_mfma_f32_16x16x32_bf16(Bt[n][k], At[m][k], acc[ai][bj][m][n], 0, 0, 0); __builtin_amdgcn_s_setprio(0); } while (0)
#define PG8_WAIT_V(n) asm volatile("s_waitcnt vmcnt(" #n ")" ::: "memory")
#define PG8_WAIT_L(n) asm volatile("s_waitcnt lgkmcnt(" #n ")" ::: "memory")
#define PG8_BAR __builtin_amdgcn_s_barrier()
#define PG8_SCHED __builtin_amdgcn_sched_barrier(0)
    Unit cur, nxt; int ui = 0;
    if (!S.next(0, cur)) return;
    f32x4 acc[2][2][4][2];
#pragma unroll
    for (int a = 0; a < 2; ++a)
#pragma unroll
        for (int b = 0; b < 2; ++b)
#pragma unroll
            for (int m = 0; m < 4; ++m)
#pragma unroll
                for (int n = 0; n < 2; ++n) acc[a][b][m][n] = (f32x4){0.f, 0.f, 0.f, 0.f};
    bf16x8 At[4][2], B0[2][2], B1[2][2];
    const char* cA = (const char*)g.A + (size_t)cur.pm * tstepA; const char* cB = (const char*)g.Bt + (size_t)cur.pn * tstepB;
    PG8_STAGE(PG8_SB(0, 0), cB, voffB); PG8_STAGE(PG8_SB(0, 1), cB + hstepB, voffB); PG8_STAGE(PG8_SA(0, 0), cA, voffA); PG8_STAGE(PG8_SA(0, 1), cA + hstepA, voffA);
    if (wr == 1) PG8_BAR;
    PG8_WAIT_V(2); PG8_BAR;
    PG8_STAGE(PG8_SB(1, 0), cB + kstep, voffB); PG8_STAGE(PG8_SA(1, 0), cA + kstep, voffA); PG8_STAGE(PG8_SB(1, 1), cB + hstepB + kstep, voffB);
    PG8_WAIT_V(6); PG8_BAR;
    for (;;) {
        const bool has_next = S.next(ui + 1, nxt);
        const char* nA = has_next ? (const char*)g.A + (size_t)nxt.pm * tstepA : cA; const char* nB = has_next ? (const char*)g.Bt + (size_t)nxt.pn * tstepB : cB;
        for (int t = 0; t < nt; t += 2) {
            const bool last = (t == nt - 2);
            const char* a1 = cA + (size_t)(t + 1) * kstep;
            const char* a2 = last ? nA : cA + (size_t)(t + 2) * kstep; const char* b2 = last ? nB : cB + (size_t)(t + 2) * kstep;
            const char* a3 = a2 + kstep; const char* b3 = b2 + kstep;
            PG8_LDB(B0, 0, 0); PG8_LDB(B1, 0, 1); PG8_SCHED; PG8_LDA(At, 0, 0); PG8_STAGE(PG8_SA(1, 1), a1 + hstepA, voffA);
            PG8_WAIT_V(8); PG8_WAIT_L(0); PG8_BAR; PG8_MMA(0, 0, At, B0); PG8_MMA(0, 1, At, B1); PG8_BAR; PG8_SCHED;
            PG8_LDA(At, 0, 1); PG8_STAGE(PG8_SB(0, 0), b2, voffB); PG8_STAGE(PG8_SB(0, 1), b2 + hstepB, voffB); PG8_STAGE(PG8_SA(0, 0), a2, voffA);
            PG8_WAIT_V(8); PG8_WAIT_L(0); PG8_BAR; PG8_MMA(1, 0, At, B0); PG8_MMA(1, 1, At, B1); PG8_BAR; PG8_SCHED;
            PG8_LDB(B0, 1, 0); PG8_LDB(B1, 1, 1); PG8_SCHED; PG8_LDA(At, 1, 0); PG8_STAGE(PG8_SA(0, 1), a2 + hstepA, voffA);
            PG8_WAIT_V(8); PG8_WAIT_L(0); PG8_BAR; PG8_MMA(0, 0, At, B0); PG8_MMA(0, 1, At, B1); PG8_BAR; PG8_SCHED;
            PG8_LDA(At, 1, 1); PG8_STAGE(PG8_SB(1, 0), b3, voffB); PG8_STAGE(PG8_SB(1, 1), b3 + hstepB, voffB); PG8_STAGE(PG8_SA(1, 0), a3, voffA);
            PG8_WAIT_V(8); PG8_WAIT_L(0); PG8_BAR; PG8_MMA(1, 0, At, B0); PG8_MMA(1, 1, At, B1); PG8_BAR; PG8_SCHED;
        }
        if (wr == 0) PG8_BAR;
        E(acc, cur, wr, wc, fr, fq);
        if (!has_next) break;
#pragma unroll
        for (int a = 0; a < 2; ++a)
#pragma unroll
            for (int b = 0; b < 2; ++b)
#pragma unroll
                for (int m = 0; m < 4; ++m)
#pragma unroll
                    for (int n = 0; n < 2; ++n) acc[a][b][m][n] = (f32x4){0.f, 0.f, 0.f, 0.f};
        cur = nxt; cA = nA; cB = nB; ++ui;
        if (wr == 1) PG8_BAR;
    }
    PG8_WAIT_V(0);
    PG8_BAR;
#undef PG8_SA
#undef PG8_SB
#undef PG8_STAGE
#undef PG8_LDA
#undef PG8_LDB
#undef PG8_MMA
#undef PG8_WAIT_V
#undef PG8_WAIT_L
#undef PG8_BAR
#undef PG8_SCHED
}
}

struct EpiSwiglu {
    static constexpr bool PERM = true;
    bf16_t* O;
    __device__ __forceinline__ void operator()(const f32x4 (&acc)[2][2][4][2], const pg8::Unit& u, int wr, int wc, int fr, int fq) const {
        asm volatile("" : "+v"(fr), "+v"(fq));
        const int row0 = u.pm * 256 + wr * 64 + fr, col0 = u.pn * 128 + wc * 32 + 8 * fq;
#pragma unroll
        for (int ai = 0; ai < 2; ++ai)
#pragma unroll
            for (int m = 0; m < 4; ++m) {
                bf16_t* rowp = O + (size_t)(row0 + ai * 128 + m * 16) * DFF + col0;
                float h[8];
#pragma unroll
                for (int n = 0; n < 2; ++n)
#pragma unroll
                    for (int j = 0; j < 4; ++j) h[n * 4 + j] = siluf_(acc[ai][0][m][n][j]) * acc[ai][1][m][n][j];
                u32x4 w; w.x = cvt_pk_bf16(h[0], h[1]); w.y = cvt_pk_bf16(h[2], h[3]); w.z = cvt_pk_bf16(h[4], h[5]); w.w = cvt_pk_bf16(h[6], h[7]);
                *(u32x4*)rowp = w;
            }
    }
};
template <bool XF32>
struct EpiResid {
    static constexpr bool PERM = true;
    const float* xres; const float* gmod; bf16_t* Y; const f32x2* stats; const float* lng; const float* lnb; float coef; int pad_;
    __device__ __forceinline__ void operator()(const f32x4 (&acc)[2][2][4][2], const pg8::Unit& u, int wr, int wc, int fr, int fq) const {
        asm volatile("" : "+v"(fr), "+v"(fq));
        const int row0 = u.pm * 256 + wr * 64 + fr, col0 = u.pn * 256 + wc * 32 + 8 * fq, b = u.pm >> 4;
        const float* gp = gmod + (size_t)b * NMOD + col0;
#pragma unroll
        for (int bj = 0; bj < 2; ++bj) {
            const f32x4 g0 = *(const f32x4*)(gp + bj * 128) * coef, g1 = *(const f32x4*)(gp + bj * 128 + 4) * coef;
            f32x4 a0 = (f32x4){1.f, 1.f, 1.f, 1.f}, a1 = a0, c0 = (f32x4){0.f, 0.f, 0.f, 0.f}, c1 = c0;
            if (!XF32) { a0 = *(const f32x4*)(lng + col0 + bj * 128); a1 = *(const f32x4*)(lng + col0 + bj * 128 + 4); c0 = *(const f32x4*)(lnb + col0 + bj * 128); c1 = *(const f32x4*)(lnb + col0 + bj * 128 + 4); }
#pragma unroll
            for (int ai = 0; ai < 2; ++ai) {
                {
                    f32x4 x0[4], x1[4]; f32x2 st[4];
#pragma unroll
                    for (int m = 0; m < 4; ++m) { const size_t row = (size_t)(row0 + ai * 128 + m * 16), off = row * DM + col0 + bj * 128;
                        if (XF32) { x0[m] = *(const f32x4*)(xres + off); x1[m] = *(const f32x4*)(xres + off + 4); }
                        else { const u32x4 w = *(const u32x4*)(Y + off); st[m] = stats[row];
                            x0[m] = (f32x4){__uint_as_float(w.x << 16), __uint_as_float(w.x & 0xffff0000u), __uint_as_float(w.y << 16), __uint_as_float(w.y & 0xffff0000u)};
                            x1[m] = (f32x4){__uint_as_float(w.z << 16), __uint_as_float(w.z & 0xffff0000u), __uint_as_float(w.w << 16), __uint_as_float(w.w & 0xffff0000u)}; } }
#pragma unroll
                    for (int m = 0; m < 4; ++m) { const size_t off = (size_t)(row0 + ai * 128 + m * 16) * DM + col0 + bj * 128;
                        f32x4 r0 = x0[m], r1 = x1[m];
                        if (!XF32) { r0 = (r0 - st[m].x) * st[m].y * a0 + c0; r1 = (r1 - st[m].x) * st[m].y * a1 + c1; }
                        const f32x4 y0 = r0 * ALPHA + g0 * acc[ai][bj][m][0], y1 = r1 * ALPHA + g1 * acc[ai][bj][m][1];
                        u32x4 w; w.x = cvt_pk_bf16(y0[0], y0[1]); w.y = cvt_pk_bf16(y0[2], y0[3]); w.z = cvt_pk_bf16(y1[0], y1[1]); w.w = cvt_pk_bf16(y1[2], y1[3]);
                        *(u32x4*)(Y + off) = w; }
                    asm volatile("" ::: "memory");
                }
            }
        }
    }
};
struct EpiGate {
    static constexpr bool PERM = true;
    const bf16_t* gate; int gcol0; const bf16_t* addsrc; bf16_t* O;
    __device__ __forceinline__ void operator()(const f32x4 (&acc)[2][2][4][2], const pg8::Unit& u, int wr, int wc, int fr, int fq) const {
        asm volatile("" : "+v"(fr), "+v"(fq));
        const int row0 = u.pm * 256 + wr * 64 + fr, col0 = u.pn * 256 + wc * 32 + 8 * fq;
#pragma unroll
        for (int ai = 0; ai < 2; ++ai) {
            u32x4 gw[4][2], aw[4][2];
#pragma unroll
            for (int m = 0; m < 4; ++m)
#pragma unroll
                for (int bj = 0; bj < 2; ++bj) { const size_t row = (size_t)(row0 + ai * 128 + m * 16); const int c = col0 + bj * 128;
                    gw[m][bj] = *(const u32x4*)(gate + row * 2048 + gcol0 + c);
                    if (addsrc) aw[m][bj] = *(const u32x4*)(addsrc + row * DM + c); }
#pragma unroll
            for (int m = 0; m < 4; ++m)
#pragma unroll
                for (int bj = 0; bj < 2; ++bj) { const size_t row = (size_t)(row0 + ai * 128 + m * 16); const int c = col0 + bj * 128;
                    float v[8];
#pragma unroll
                    for (int n = 0; n < 2; ++n)
#pragma unroll
                        for (int j = 0; j < 4; ++j) v[n * 4 + j] = acc[ai][bj][m][n][j];
#pragma unroll
                    for (int q = 0; q < 4; ++q) { v[2 * q] *= __uint_as_float(gw[m][bj][q] << 16); v[2 * q + 1] *= __uint_as_float(gw[m][bj][q] & 0xffff0000u); }
                    if (addsrc) {
#pragma unroll
                        for (int q = 0; q < 4; ++q) { v[2 * q] += __uint_as_float(aw[m][bj][q] << 16); v[2 * q + 1] += __uint_as_float(aw[m][bj][q] & 0xffff0000u); } }
                    u32x4 w; w.x = cvt_pk_bf16(v[0], v[1]); w.y = cvt_pk_bf16(v[2], v[3]); w.z = cvt_pk_bf16(v[4], v[5]); w.w = cvt_pk_bf16(v[6], v[7]);
                    *(u32x4*)(O + row * DM + c) = w; }
            asm volatile("" ::: "memory");
        }
    }
};
struct EpiCmp1 {
    static constexpr bool PERM = true;
    unsigned char* ws; int kv;
    __device__ __forceinline__ void operator()(const f32x4 (&acc)[2][2][4][2], const pg8::Unit& u, int wr, int wc, int fr, int fq) const {
        asm volatile("" : "+v"(fr), "+v"(fq));
        unsigned char* w_ = launder_ptr(ws);
        const float* bias1p = (const float*)(w_ + WS_BIAS1P) + (kv ? 8 * 256 : 0); bf16_t* O = (bf16_t*)(w_ + (kv ? WS_HIDV : WS_HIDK));
        const int row0 = u.pm * 256 + wr * 64 + fr, col0 = wc * 32 + 8 * fq;
        float bv[2][8];
#pragma unroll
        for (int bj = 0; bj < 2; ++bj)
#pragma unroll
            for (int e = 0; e < 8; ++e) { float s = 0.f;
#pragma unroll
                for (int kc = 0; kc < 8; ++kc) s += bias1p[kc * 256 + col0 + bj * 128 + e];
                bv[bj][e] = s; }
#pragma unroll
        for (int ai = 0; ai < 2; ++ai)
#pragma unroll
            for (int m = 0; m < 4; ++m) {
                const size_t row = (size_t)(row0 + ai * 128 + m * 16);
#pragma unroll
                for (int bj = 0; bj < 2; ++bj) {
                    float v[8];
#pragma unroll
                    for (int n = 0; n < 2; ++n)
#pragma unroll
                        for (int j = 0; j < 4; ++j) v[n * 4 + j] = siluf_(acc[ai][bj][m][n][j] + bv[bj][n * 4 + j]);
                    u32x4 w; w.x = cvt_pk_bf16(v[0], v[1]); w.y = cvt_pk_bf16(v[2], v[3]); w.z = cvt_pk_bf16(v[4], v[5]); w.w = cvt_pk_bf16(v[6], v[7]);
                    *(u32x4*)(O + row * 256 + col0 + bj * 128) = w;
                }
            }
    }
};
struct EpiMix {
    static constexpr bool PERM = true;
    unsigned char* ws_m; unsigned char* dout_m;
    __device__ __forceinline__ void operator()(const f32x4 (&acc)[2][2][4][2], const pg8::Unit& u, int wr, int wc, int fr, int fq) const {
        asm volatile("" : "+v"(fr), "+v"(fq));
        unsigned char* ws = launder_ptr(ws_m); unsigned char* dout = launder_ptr(dout_m);
        const f32x2* rope = (const f32x2*)(ws + WS_ROPE);
        const int slot = u.pn * 4 + wc, b = u.pm >> 4;
        const int t0 = (u.pm & 15) * 256 + wr * 64 + fr;
        int kind;
        bool rope_on = false, f16o = false, sig = false, kit = false; float scale = 1.f;
        unsigned short* dst = nullptr; int ld = 0, col0 = 0;
        if (slot < 8)       { kind = 0; rope_on = true; scale = QSCALE; dst = (unsigned short*)(ws + WS_QA) + (size_t)b * SEQ * 512; ld = 512; col0 = 64 * slot; }
        else if (slot < 12) { kind = 0; rope_on = true; f16o = true; dst = (unsigned short*)(ws + WS_QI) + (size_t)b * SEQ * 256; ld = 256; col0 = 64 * (slot - 8); }
        else if (slot < 20) { kind = 0; rope_on = true; scale = QSCALE; dst = (unsigned short*)(dout + DO_QB) + (size_t)b * SEQ * 512; ld = 512; col0 = 64 * (slot - 12); }
        else if (slot < 26) { kind = 0; rope_on = true; const int w = (slot - 20) >> 1, g = (slot - 20) & 1;
                              dst = (unsigned short*)(ws + (w == 0 ? WS_KC : (w == 1 ? WS_KS : WS_KW))) + (size_t)(b * 2 + g) * SEQ * 64; ld = 64; col0 = 0; }
        else if (slot == 26) { kind = 0; rope_on = true; f16o = true; kit = true; dst = (unsigned short*)(ws + WS_KI) + (size_t)b * SEQ * 64; ld = 64; col0 = 0; }
        else if (slot == 27) { kind = 2; }
        else if (slot < 30) { kind = 0; dst = (unsigned short*)(ws + WS_VC) + (size_t)(b * 2 + (slot - 28)) * SEQ * 64; ld = 64; col0 = 0; }
        else if (slot < 34) { kind = 1; const int w = (slot - 30) >> 1, g = (slot - 30) & 1; dst = (unsigned short*)(ws + (w == 0 ? WS_VST : WS_VWT)) + (size_t)(b * 2 + g) * 64 * SEQ; }
        else if (slot < 36) { kind = 0; dst = (unsigned short*)(ws + WS_KVL) + (size_t)b * SEQ * 128; ld = 128; col0 = 64 * (slot - 34); }
        else                { kind = 0; sig = true; dst = (unsigned short*)(ws + WS_GATE) + (size_t)b * SEQ * 2048; ld = 2048; col0 = 64 * (slot - 36); }
        if (kind == 0) {
#pragma unroll
            for (int ai = 0; ai < 2; ++ai)
#pragma unroll
                for (int m = 0; m < 4; ++m) {
                    const int t = t0 + ai * 128 + m * 16;
                    float x1[8], x2[8];
#pragma unroll
                    for (int n = 0; n < 2; ++n)
#pragma unroll
                        for (int j = 0; j < 4; ++j) { x1[n * 4 + j] = acc[ai][0][m][n][j]; x2[n * 4 + j] = acc[ai][1][m][n][j]; }
                    if (rope_on) {
                        const f32x4* rp = (const f32x4*)(rope + (size_t)t * 32 + 8 * fq);
#pragma unroll
                        for (int q = 0; q < 4; ++q) { const f32x4 cs = rp[q];
                            const float a0 = x1[2 * q], b0 = x2[2 * q], a1 = x1[2 * q + 1], b1 = x2[2 * q + 1];
                            x1[2 * q] = (a0 * cs[0] - b0 * cs[1]) * scale; x2[2 * q] = (a0 * cs[1] + b0 * cs[0]) * scale;
                            x1[2 * q + 1] = (a1 * cs[2] - b1 * cs[3]) * scale; x2[2 * q + 1] = (a1 * cs[3] + b1 * cs[2]) * scale; }
                    }
                    if (sig) {
#pragma unroll
                        for (int e = 0; e < 8; ++e) { x1[e] = sigmoidf_(x1[e]); x2[e] = sigmoidf_(x2[e]); }
                    }
                    u32x4 w1, w2;
                    if (f16o) { w1.x = cvt_pk_f16(x1[0], x1[1]); w1.y = cvt_pk_f16(x1[2], x1[3]); w1.z = cvt_pk_f16(x1[4], x1[5]); w1.w = cvt_pk_f16(x1[6], x1[7]);
                                w2.x = cvt_pk_f16(x2[0], x2[1]); w2.y = cvt_pk_f16(x2[2], x2[3]); w2.z = cvt_pk_f16(x2[4], x2[5]); w2.w = cvt_pk_f16(x2[6], x2[7]); }
                    else      { w1.x = cvt_pk_bf16(x1[0], x1[1]); w1.y = cvt_pk_bf16(x1[2], x1[3]); w1.z = cvt_pk_bf16(x1[4], x1[5]); w1.w = cvt_pk_bf16(x1[6], x1[7]);
                                w2.x = cvt_pk_bf16(x2[0], x2[1]); w2.y = cvt_pk_bf16(x2[2], x2[3]); w2.z = cvt_pk_bf16(x2[4], x2[5]); w2.w = cvt_pk_bf16(x2[6], x2[7]); }
                    unsigned short* rowp = kit ? dst + (size_t)(t >> 5) * 2048 + (fq * 32 + (t & 31)) * 8 : dst + (size_t)t * ld + col0 + 8 * fq;
                    *(u32x4*)rowp = w1; *(u32x4*)(rowp + (kit ? 1024 : 32)) = w2;
                    asm volatile("" ::: "memory");
                }
        } else if (kind == 1) {
#pragma unroll
            for (int ai = 0; ai < 2; ++ai)
#pragma unroll
                for (int m = 0; m < 4; ++m) {
                    const int t = t0 + ai * 128 + m * 16;
#pragma unroll
                    for (int bj = 0; bj < 2; ++bj)
#pragma unroll
                        for (int n = 0; n < 2; ++n)
#pragma unroll
                            for (int j = 0; j < 4; ++j) { const int d = 32 * bj + 8 * fq + 4 * n + j;
                                dst[(size_t)(t >> 7) * 8192 + d * 128 + (t & 127)] = (unsigned short)(cvt_pk_bf16(acc[ai][bj][m][n][j], 0.f) & 0xffffu); }
                }
        } else {
            float* WI = (float*)(dout + DO_WI) + (size_t)b * SEQ * 4; float* GB = (float*)(dout + DO_GB) + (size_t)b * SEQ * 24;
#pragma unroll
            for (int ai = 0; ai < 2; ++ai)
#pragma unroll
                for (int m = 0; m < 4; ++m) {
                    const int t = t0 + ai * 128 + m * 16;
#pragma unroll
                    for (int n = 0; n < 2; ++n) { const int e0 = 8 * fq + 4 * n; const f32x4 v = acc[ai][0][m][n];
                        if (e0 == 0) { *(f32x4*)(WI + (size_t)t * 4) = v * 0.5f; }
                        else if (e0 < 28) { f32x4 s; s[0] = sigmoidf_(v[0]); s[1] = sigmoidf_(v[1]); s[2] = sigmoidf_(v[2]); s[3] = sigmoidf_(v[3]); *(f32x4*)(GB + (size_t)t * 24 + (e0 - 4)) = s; } }
                }
        }
    }
};

constexpr float RESCALE_THR = 8.0f;
struct AttnAcc { f32x16 o0, o1; float m, l; };
__device__ __forceinline__ void attn_init(AttnAcc& A) {
#pragma unroll
    for (int r = 0; r < 16; ++r) { A.o0[r] = 0.f; A.o1[r] = 0.f; }
    A.m = -1e30f; A.l = 0.f;
}
__device__ __forceinline__ void attn_step(AttnAcc& A, const bf16x8 (&qf)[4], const bf16_t* __restrict__ Kp, const bf16_t* __restrict__ VTp, int ldv, unsigned vmask, int hi) {
    f32x16 s;
#pragma unroll
    for (int r = 0; r < 16; ++r) s[r] = 0.f;
#pragma unroll
    for (int ks = 0; ks < 4; ++ks) { const bf16x8 kf = *(const bf16x8*)(Kp + ks * 16); s = __builtin_amdgcn_mfma_f32_32x32x16_bf16(kf, qf[ks], s, 0, 0, 0); }
    s16x4 vf[2][2][2];
#pragma unroll
    for (int dt = 0; dt < 2; ++dt)
#pragma unroll
        for (int st = 0; st < 2; ++st) { vf[dt][st][0] = *(const s16x4*)(VTp + (size_t)dt * 32 * ldv + st * 16); vf[dt][st][1] = *(const s16x4*)(VTp + (size_t)dt * 32 * ldv + st * 16 + 8); }
    float mx = -INFINITY;
#pragma unroll
    for (int r = 0; r < 16; ++r) { const int ko = (r & 3) + 8 * (r >> 2) + 4 * hi; if (!((vmask >> ko) & 1u)) s[r] = -INFINITY; mx = fmaxf(mx, s[r]); }
    mx = max32(mx);
    const float mn = fmaxf(A.m, mx), alpha = __builtin_amdgcn_exp2f(A.m - mn); A.m = mn;
    float ls = 0.f;
#pragma unroll
    for (int r = 0; r < 16; ++r) { s[r] = __builtin_amdgcn_exp2f(s[r] - mn); ls += s[r]; }
    A.l = A.l * alpha + ls;
#pragma unroll
    for (int r = 0; r < 16; ++r) { A.o0[r] *= alpha; A.o1[r] *= alpha; }
    u32x4 p0, p1;
    p0.x = cvt_pk_bf16(s[0], s[1]); p0.y = cvt_pk_bf16(s[2], s[3]); p0.z = cvt_pk_bf16(s[4], s[5]); p0.w = cvt_pk_bf16(s[6], s[7]);
    p1.x = cvt_pk_bf16(s[8], s[9]); p1.y = cvt_pk_bf16(s[10], s[11]); p1.z = cvt_pk_bf16(s[12], s[13]); p1.w = cvt_pk_bf16(s[14], s[15]);
    const bf16x8 pb0 = __builtin_bit_cast(bf16x8, p0), pb1 = __builtin_bit_cast(bf16x8, p1);
#define VFR(dt, st) (bf16x8){vf[dt][st][0][0], vf[dt][st][0][1], vf[dt][st][0][2], vf[dt][st][0][3], vf[dt][st][1][0], vf[dt][st][1][1], vf[dt][st][1][2], vf[dt][st][1][3]}
    A.o0 = __builtin_amdgcn_mfma_f32_32x32x16_bf16(VFR(0, 0), pb0, A.o0, 0, 0, 0);
    A.o0 = __builtin_amdgcn_mfma_f32_32x32x16_bf16(VFR(0, 1), pb1, A.o0, 0, 0, 0);
    A.o1 = __builtin_amdgcn_mfma_f32_32x32x16_bf16(VFR(1, 0), pb0, A.o1, 0, 0, 0);
    A.o1 = __builtin_amdgcn_mfma_f32_32x32x16_bf16(VFR(1, 1), pb1, A.o1, 0, 0, 0);
#undef VFR
}
__device__ __forceinline__ float attn_inv_l(const AttnAcc& A) { const float l = sum32(A.l); return l > 0.f ? __builtin_amdgcn_rcpf(l) : 0.f; }
__device__ __forceinline__ void attn_store(const f32x16& o0, const f32x16& o1, bf16_t* yrow  , int hi) {
#pragma unroll
    for (int k4 = 0; k4 < 4; ++k4) {
        u32x2 w0, w1;
        w0.x = cvt_pk_bf16(o0[4 * k4], o0[4 * k4 + 1]); w0.y = cvt_pk_bf16(o0[4 * k4 + 2], o0[4 * k4 + 3]);
        w1.x = cvt_pk_bf16(o1[4 * k4], o1[4 * k4 + 1]); w1.y = cvt_pk_bf16(o1[4 * k4 + 2], o1[4 * k4 + 3]);
        *(u32x2*)(yrow + 8 * k4 + 4 * hi) = w0; *(u32x2*)(yrow + 32 + 8 * k4 + 4 * hi) = w1;
    }
}

#define XB_TMO      128
#define XB_XCNT(j)  (256  + 64 * (j))
#define XB_XSUB(j)  (1280 + 64 * (j))
#define XB_XGEN(j)  (2304 + 64 * (j))
#define XB_TOP      3328
#define XB_TOPGEN   3392
#define XCD_BAR_WORDS 3456
#define XB_SPIN_CAP (1u << 18)

__device__ __forceinline__ unsigned xb_ld(unsigned* p)              { return __hip_atomic_load(p, __ATOMIC_RELAXED, __HIP_MEMORY_SCOPE_AGENT); }
__device__ __forceinline__ unsigned xb_add(unsigned* p, unsigned v) { return __hip_atomic_fetch_add(p, v, __ATOMIC_RELAXED, __HIP_MEMORY_SCOPE_AGENT); }
__device__ __forceinline__ unsigned xb_xcc_id() { return (unsigned)__builtin_amdgcn_s_getreg((3 << 11) | 20) & 0xFu; }
#define XB_SPIN(cond, bar) do { unsigned _sp = 0; while (cond) { __builtin_amdgcn_s_sleep(1); \
    if ((++_sp & 255u) == 0u) { if (xb_ld(&(bar)[XB_TMO])) break; if (_sp > XB_SPIN_CAP) { atomicAdd(&(bar)[XB_TMO], 1u); break; } } } } while (0)

struct XcdBarrier {
    unsigned* bar; unsigned x;
    volatile LAS unsigned* st;
};

__device__ __forceinline__ XcdBarrier xcd_barrier_post(unsigned* bar, volatile LAS unsigned* st) {
    XcdBarrier b; b.bar = bar; b.x = xb_xcc_id(); b.st = st;
    if (threadIdx.x == 0) (void)xb_add(&bar[XB_XCNT(b.x)], 1u);
    return b;
}
__device__ __forceinline__ void xcd_barrier_complete(unsigned* bar, unsigned x, unsigned& nloc, unsigned& nx) {
    const unsigned G = gridDim.x * gridDim.y * gridDim.z;
    unsigned sum, cnt, mine, sp = 0u;
    for (;;) {
        sum = 0u; cnt = 0u; mine = 0u;
#pragma unroll
        for (unsigned j = 0; j < 16; ++j) { const unsigned c = xb_ld(&bar[XB_XCNT(j)]); sum += c; cnt += (c > 0u) ? 1u : 0u; mine = (j == x) ? c : mine; }
        if (sum == G) break;
        __builtin_amdgcn_s_sleep(1);
        if ((++sp & 255u) == 0u) { if (xb_ld(&bar[XB_TMO])) break; if (sp > XB_SPIN_CAP) { atomicAdd(&bar[XB_TMO], 1u); break; } }
    }
    nloc = mine > 0u ? mine : 1u; nx = cnt > 0u ? cnt : 1u;
}

__device__ __forceinline__ void xcd_barrier(const XcdBarrier& b) {
    asm volatile("s_waitcnt vmcnt(0)" ::: "memory");
    __syncthreads();
    if (threadIdx.x == 0) {
        unsigned* bar = b.bar;
        __builtin_amdgcn_s_waitcnt(0);
        unsigned nloc = b.st[0], nx = b.st[1];
        if (nloc == 0u) { xcd_barrier_complete(bar, b.x, nloc, nx); b.st[0] = nloc; b.st[1] = nx; }
        const unsigned old = xb_add(&bar[XB_XSUB(b.x)], 1u);
        const unsigned gen = old / nloc;
        if (old + 1u == (gen + 1u) * nloc) {
            __builtin_amdgcn_fence(__ATOMIC_RELEASE, "agent");
            asm volatile("s_waitcnt vmcnt(0)" ::: "memory");
            const unsigned og = xb_add(&bar[XB_TOP], 1u);
            const unsigned tg = og / nx;
            if (og + 1u == (tg + 1u) * nx) xb_add(&bar[XB_TOPGEN], 1u);
            else XB_SPIN(xb_ld(&bar[XB_TOPGEN]) == tg, bar);
            __builtin_amdgcn_fence(__ATOMIC_ACQUIRE, "agent");
            xb_add(&bar[XB_XGEN(b.x)], 1u);
            asm volatile("s_waitcnt vmcnt(0)" ::: "memory");
        } else {
            XB_SPIN(xb_ld(&bar[XB_XGEN(b.x)]) == gen, bar);
            __builtin_amdgcn_fence(__ATOMIC_ACQUIRE, "agent");
            asm volatile("s_waitcnt vmcnt(0)" ::: "memory");
        }
    }
    __syncthreads();
}

#define INP(k) ((const float*)(const GAS float*)(F.in[k]))
struct Frame {
    LAS unsigned char* lds; unsigned char* ws; unsigned char* dout; const float* const* in;
    int tid, lane, wave, G, blk;
};

__device__ __forceinline__ void transpose_item(const float* W, int K, int N, bf16_t* WT, int k0, int srccol, int dst_row0, LAS float* scr, int lane, const float* kscale) {
    const int sc_ = srccol < 0 ? 0 : srccol; float tv[32];
#pragma unroll
    for (int i = 0; i < 32; ++i) { const int kk = 2 * i + (lane >> 5); tv[i] = __builtin_nontemporal_load(W + (size_t)(k0 + kk) * N + sc_); }
#pragma unroll
    for (int i = 0; i < 32; ++i) { const int kk = 2 * i + (lane >> 5); float v = srccol >= 0 ? tv[i] : 0.f; if (kscale) v *= kscale[k0 + kk]; scr[kk * 33 + (lane & 31)] = v; }
    LDS_WAIT(); asm volatile("" ::: "memory");
    const int c = lane & 7;
#pragma unroll
    for (int j = 0; j < 4; ++j) { const int n = (lane >> 3) + 8 * j; const LAS float* s = scr + (8 * c) * 33 + n;
        u32x4 o; o.x = cvt_pk_bf16(s[0 * 33], s[1 * 33]); o.y = cvt_pk_bf16(s[2 * 33], s[3 * 33]); o.z = cvt_pk_bf16(s[4 * 33], s[5 * 33]); o.w = cvt_pk_bf16(s[6 * 33], s[7 * 33]);
        *(u32x4*)(WT + (size_t)(dst_row0 + n) * K + k0 + 8 * c) = o; }
    LDS_WAIT(); asm volatile("" ::: "memory");
}
__device__ __forceinline__ int mix_srccol(int slot, int bj, int e) {
    int base;
    if (slot < 8) base = 0 + 64 * slot;
    else if (slot < 12) base = 640 + 64 * (slot - 8);
    else if (slot < 20) base = 964 + 64 * (slot - 12);
    else if (slot < 22) base = 1476 + 64 * (slot - 20);
    else if (slot < 24) base = 1732 + 64 * (slot - 22);
    else if (slot < 26) base = 1988 + 64 * (slot - 24);
    else if (slot == 26) base = 896;
    else if (slot == 27) { if (bj == 1) return -1; if (e < 4) return 960 + e; if (e < 28) return 2244 + (e - 4); return -1; }
    else if (slot < 30) base = 1604 + 64 * (slot - 28);
    else if (slot < 32) base = 1860 + 64 * (slot - 30);
    else if (slot < 34) base = 2116 + 64 * (slot - 32);
    else if (slot < 36) base = 512 + 64 * (slot - 34);
    else base = 2268 + 64 * (slot - 36);
    return base + 32 * bj + e;
}
__device__ __forceinline__ void sincos_d(double x, float& sn, float& cs) {
    const double n = rint(x * 0.6366197723675814);
    double r = fma(-n, 1.5707963267341256, x); r = fma(-n, 6.077100506506192e-11, r);
    const double r2 = r * r;
    double sp = -7.647163731819816e-13; sp = fma(sp, r2, 1.6059043836821613e-10); sp = fma(sp, r2, -2.505210838544172e-08); sp = fma(sp, r2, 2.7557319223985893e-06);
    sp = fma(sp, r2, -0.0001984126984126984); sp = fma(sp, r2, 0.008333333333333333); sp = fma(sp, r2, -0.16666666666666666); sp = fma(sp * r2, r, r);
    double cp = 4.779477332387385e-14; cp = fma(cp, r2, -1.1470745597729725e-11); cp = fma(cp, r2, 2.08767569878681e-09); cp = fma(cp, r2, -2.755731922398589e-07);
    cp = fma(cp, r2, 2.48015873015873e-05); cp = fma(cp, r2, -0.001388888888888889); cp = fma(cp, r2, 0.041666666666666664); cp = fma(cp, r2, -0.5); cp = fma(cp, r2, 1.0);
    const int q = ((int)n) & 3;
    const double s_ = (q & 1) ? cp : sp, c_ = (q & 1) ? sp : cp;
    sn = (float)((q & 2) ? -s_ : s_); cs = (float)(((q + 1) & 2) ? -c_ : c_);
}

__device__ __forceinline__ void stage_prologue(Frame& F, const Args& args) {
    LAS float* scr = (LAS float*)(F.lds + F.wave * 8448);
    LAS float* cact = (LAS float*)(F.lds + 69632);
    const float* cin = INP(1);
    for (int i = F.tid; i < NB * DM; i += NTHREADS) cact[i] = siluf_(cin[i]);
    __syncthreads();
    const int gw = F.blk * NWAVES + F.wave, NGW = F.G * NWAVES;
    {
        const float* wada = INP(2); float* modp = (float*)(F.ws + WS_MODP);
        for (int it = gw; it < 144 * 8; it += NGW) {
            const int cgp = it % 144, kc = it / 144, n = cgp * 64 + F.lane;
            float a[8];
#pragma unroll
            for (int b = 0; b < 8; ++b) a[b] = 0.f;
#pragma unroll 32
            for (int k = kc * 128; k < kc * 128 + 128; ++k) { const float w = __builtin_nontemporal_load(wada + (size_t)k * NMOD + n);
#pragma unroll
                for (int b = 0; b < 8; ++b) a[b] += cact[b * DM + k] * w; }
#pragma unroll
            for (int b = 0; b < 8; ++b) modp[((size_t)kc * 8 + b) * NMOD + n] = a[b];
        }
    }
    {
        float* b1p = (float*)(F.ws + WS_BIAS1P);
        for (int it = gw; it < 64; it += NGW) {
            const int kv = it >> 5, cgp = (it >> 3) & 3, kc = it & 7, n = cgp * 64 + F.lane;
            const float* pe = INP(kv ? 14 : 11); const float* w1 = INP(kv ? 15 : 12);
            float a = 0.f;
#pragma unroll 64
            for (int k = kc * 256; k < kc * 256 + 256; ++k) a += pe[k] * w1[(size_t)k * 256 + n];
            b1p[(kv * 8 + kc) * 256 + n] = a;
        }
    }
    {
        f32x2* rope = (f32x2*)(F.ws + WS_ROPE);
        for (int i = F.blk * NTHREADS + F.tid; i < SEQ * 32; i += F.G * NTHREADS) {
            const int pos = i >> 5, d = i & 31; const float ang = (float)pos * args.inv_freq[d];
            float sn, cs; sincos_d((double)ang, sn, cs); rope[i] = (f32x2){cs, sn};
        }
    }
    {
        constexpr int I_FIN = 16 * 176, I_FOUT = 44 * 32, I_MIX = 16 * 136, I_BR = 8 * 32, I_MO = 16 * 32, I_C1 = 32 * 8, I_C2 = 4 * 2, I_KV = 2 * 4;
        constexpr int NITEMS = I_FIN + I_FOUT + I_MIX + 2 * I_BR + I_MO + 2 * I_C1 + 2 * I_C2 + I_KV;
        for (int it = gw; it < NITEMS; it += NGW) {
            int r = it; const int l31 = F.lane & 31;
            if (r < I_FIN) { const int w = 0; const int kb = r / 176, ng = r % 176;
                const int pn = ng >> 3, half = (ng >> 2) & 1, sub = ng & 3; const int src = half * DFF + pn * 128 + sub * 32 + l31;
                transpose_item(INP(w ? 22 : 4), DM, NFF, (bf16_t*)(F.ws + (w ? WS_W2IN : WS_W1IN)), 64 * kb, src, 32 * ng, scr, F.lane, nullptr); continue; }
            r -= I_FIN;
            if (r < I_FOUT) { const int w = 0; const int kb = r / 32, ng = r % 32;
                transpose_item(INP(w ? 23 : 5), DFF, DM, (bf16_t*)(F.ws + (w ? WS_W2OUT : WS_W1OUT)), 64 * kb, 32 * ng + l31, 32 * ng, scr, F.lane, nullptr); continue; }
            r -= I_FOUT;
            if (r < I_MIX) { const int kb = r / 136, ng = r % 136; const int pn = ng >> 3, bj = (ng >> 2) & 1, wc = ng & 3;
                transpose_item(INP(8), DM, 4316, (bf16_t*)(F.ws + WS_WMIX), 64 * kb, mix_srccol(pn * 4 + wc, bj, l31), 32 * ng, scr, F.lane, nullptr); continue; }
            r -= I_MIX;
            if (r < 2 * I_BR) { const int w = r / I_BR; r -= w * I_BR; const int kb = r / 32, ng = r % 32;
                transpose_item(INP(w ? 18 : 17), 512, DM, (bf16_t*)(F.ws + (w ? WS_WBRB : WS_WBRA)), 64 * kb, 32 * ng + l31, 32 * ng, scr, F.lane, nullptr); continue; }
            r -= 2 * I_BR;
            if (r < I_MO) { const int kb = r / 32, ng = r % 32;
                transpose_item(INP(19), DM, DM, (bf16_t*)(F.ws + WS_WMO), 64 * kb, 32 * ng + l31, 32 * ng, scr, F.lane, nullptr); continue; }
            r -= I_MO;
            if (r < 2 * I_C1) { const int w = r / I_C1; r -= w * I_C1; const int kb = r / 8, ng = r % 8;
                transpose_item(INP(w ? 15 : 12), 2048, 256, (bf16_t*)(F.ws + (w ? WS_WC1V : WS_WC1K)), 64 * kb, 32 * ng + l31, 32 * ng, scr, F.lane, nullptr); continue; }
            r -= 2 * I_C1;
            if (r < 2 * I_C2) { const int w = r / I_C2; r -= w * I_C2; const int kb = r / 2, ng = r % 2;
                transpose_item(INP(w ? 16 : 13), 256, 64, (bf16_t*)(F.ws + (w ? WS_WC2V : WS_WC2K)), 64 * kb, 32 * ng + l31, 32 * ng, scr, F.lane, nullptr); continue; }
            r -= 2 * I_C2;
            { const int kb = r / 4, ng = r % 4;
                transpose_item(INP(10), 128, 128, (bf16_t*)(F.ws + WS_WKVUP), 64 * kb, 32 * ng + l31, 32 * ng, scr, F.lane, INP(9)); }
        }
    }
}

__device__ __forceinline__ void ffn2_transposes(Frame& F, const Args& args, int gw, int ngw) {
    LAS float* scr = (LAS float*)(F.lds + F.wave * 8448);
    constexpr int I_FIN = 16 * 176, I_FOUT = 44 * 32;
    const int l31 = F.lane & 31;
    for (int it = gw; it < I_FIN + I_FOUT; it += ngw) {
        int r = it;
        if (r < I_FIN) { const int kb = r / 176, ng = r % 176; const int pn = ng >> 3, half = (ng >> 2) & 1, sub = ng & 3; const int src = half * DFF + pn * 128 + sub * 32 + l31;
            transpose_item(INP(22), DM, NFF, (bf16_t*)(F.ws + WS_W2IN), 64 * kb, src, 32 * ng, scr, F.lane, nullptr); continue; }
        r -= I_FIN;
        { const int kb = r / 32, ng = r % 32;
            transpose_item(INP(23), DFF, DM, (bf16_t*)(F.ws + WS_W2OUT), 64 * kb, 32 * ng + l31, 32 * ng, scr, F.lane, nullptr); }
    }
}

template <int MODE>
__device__ __forceinline__ void stage_rows(Frame& F, const bf16_t* src, float* dstf, f32x2* stats, bf16_t* dstu, const float* lng, const float* lnb, const float* sh, const float* sc) {
    const int b = F.blk >> 5;
    f32x4 g4[4], b4[4], sh4[4], sc4[4];
#pragma unroll
    for (int j = 0; j < 4; ++j) { const int c = 4 * F.lane + 256 * j;
        g4[j] = *(const f32x4*)(lng + c); b4[j] = *(const f32x4*)(lnb + c);
        if (MODE != 2) { sh4[j] = *(const f32x4*)(sh + (size_t)b * NMOD + c); sc4[j] = *(const f32x4*)(sc + (size_t)b * NMOD + c) + 1.0f; } }
    const size_t row0 = (size_t)F.blk * 128 + F.wave * 16;
    u32x2 buf[2][8][4];
#pragma unroll
    for (int r = 0; r < 8; ++r)
#pragma unroll
        for (int j = 0; j < 4; ++j) buf[0][r][j] = __builtin_nontemporal_load((const u32x2*)(src + (row0 + r) * DM + 4 * F.lane + 256 * j));
#pragma unroll
    for (int g = 0; g < 2; ++g) {
        if (g < 1) {
#pragma unroll
            for (int r = 0; r < 8; ++r)
#pragma unroll
                for (int j = 0; j < 4; ++j) buf[1][r][j] = __builtin_nontemporal_load((const u32x2*)(src + (row0 + 8 + r) * DM + 4 * F.lane + 256 * j));
        }
#pragma unroll
        for (int r = 0; r < 8; ++r) {
            const size_t row = row0 + 8 * g + r;
            f32x4 v[4];
#pragma unroll
            for (int j = 0; j < 4; ++j) { const u32x2 w = buf[g][r][j]; v[j] = (f32x4){__uint_as_float(w.x << 16), __uint_as_float(w.x & 0xffff0000u), __uint_as_float(w.y << 16), __uint_as_float(w.y & 0xffff0000u)}; }
            float s = 0.f;
#pragma unroll
            for (int j = 0; j < 4; ++j) s += (v[j][0] + v[j][1]) + (v[j][2] + v[j][3]);
            const float mean = wave_sum(s) * (1.0f / DM); float s2 = 0.f;
#pragma unroll
            for (int j = 0; j < 4; ++j) { v[j] = v[j] - mean; s2 += (v[j][0] * v[j][0] + v[j][1] * v[j][1]) + (v[j][2] * v[j][2] + v[j][3] * v[j][3]); }
            const float rstd = __builtin_amdgcn_rsqf(wave_sum(s2) * (1.0f / DM) + LN_EPS);
            if (MODE != 2 && F.lane == 0) stats[row] = (f32x2){mean, rstd};
#pragma unroll
            for (int j = 0; j < 4; ++j) { v[j] = v[j] * rstd * g4[j] + b4[j];
                if (MODE == 2) __builtin_nontemporal_store(v[j], (f32x4*)(dstf + row * DM + 4 * F.lane + 256 * j)); }
            if (MODE != 2) {
#pragma unroll
                for (int j = 0; j < 4; ++j) { const f32x4 u = v[j] * sc4[j] + sh4[j]; u32x2 w; w.x = cvt_pk_bf16(u[0], u[1]); w.y = cvt_pk_bf16(u[2], u[3]);
                    *(u32x2*)(dstu + row * DM + 4 * F.lane + 256 * j) = w; }
            }
        }
    }
}
__device__ __forceinline__ void stage_mod_u1(Frame& F) {
    const float* modp = (const float*)(F.ws + WS_MODP); float* mod = (float*)(F.ws + WS_MOD); const float* bada = INP(3);
    const int b = F.blk >> 5, sl = F.blk & 31;
    LAS float* shsc = (LAS float*)F.lds;
    for (int i = F.tid; i < 2048; i += NTHREADS) { float s = bada[i];
#pragma unroll
        for (int kc = 0; kc < 8; ++kc) s += modp[((size_t)kc * 8 + b) * NMOD + i];
        shsc[i] = s; }
    for (int i = F.tid; i < 288; i += NTHREADS) { const int n = sl * 288 + i; float s = bada[n];
#pragma unroll
        for (int kc = 0; kc < 8; ++kc) s += modp[((size_t)kc * 8 + b) * NMOD + n];
        mod[(size_t)b * NMOD + n] = s; }
    __syncthreads();
    const float* x = INP(0); bf16_t* U = (bf16_t*)(F.ws + WS_U);
    f32x4 sh4[4], sc4[4];
#pragma unroll
    for (int j = 0; j < 4; ++j) { const int c = 4 * F.lane + 256 * j; sh4[j] = *(const LAS f32x4*)(shsc + c); sc4[j] = *(const LAS f32x4*)(shsc + 1024 + c) + 1.0f; }
    for (int g = 0; g < 2; ++g) {
        const size_t rowg = (size_t)F.blk * 128 + F.wave * 16 + 8 * g;
        f32x4 xv[8][4];
#pragma unroll
        for (int r = 0; r < 8; ++r)
#pragma unroll
            for (int j = 0; j < 4; ++j) xv[r][j] = __builtin_nontemporal_load((const f32x4*)(x + (rowg + r) * DM + 4 * F.lane + 256 * j));
#pragma unroll
        for (int r = 0; r < 8; ++r)
#pragma unroll
            for (int j = 0; j < 4; ++j) { const f32x4 u = xv[r][j] * sc4[j] + sh4[j];
                u32x2 w; w.x = cvt_pk_bf16(u[0], u[1]); w.y = cvt_pk_bf16(u[2], u[3]); *(u32x2*)(U + (rowg + r) * DM + 4 * F.lane + 256 * j) = w; }
    }
    __syncthreads();
}

__device__ __forceinline__ void kvup_item(Frame& F, int it) {
    int lane = F.lane; asm volatile("" : "+v"(lane)); const int l31 = lane & 31, hi = lane >> 5;
    const size_t row = (size_t)it * 32 + l31; const int b = (it * 32) >> 12, t = (int)(row & 4095);
    const bf16_t* kvl = (const bf16_t*)(F.ws + WS_KVL) + row * 128 + hi * 8;
    const bf16_t* W = (const bf16_t*)(F.ws + WS_WKVUP);
    bf16x8 xf[8]; float ss = 0.f;
#pragma unroll
    for (int ks = 0; ks < 8; ++ks) { xf[ks] = *(const bf16x8*)(kvl + ks * 16);
#pragma unroll
        for (int j = 0; j < 8; ++j) { const float v = bf2f((unsigned short)xf[ks][j]); ss += v * v; } }
    ss = sum32(ss);
    const float rstd = __builtin_amdgcn_rsqf(ss * (1.0f / 128.0f) + LN_EPS);
    const f32x2* rope = (const f32x2*)(F.ws + WS_ROPE) + (size_t)t * 32;
    bf16_t* ka = (bf16_t*)(F.ws + WS_KA) + row * 64; bf16_t* vat = (bf16_t*)(F.ws + WS_VAT) + (size_t)b * 64 * SEQ + (size_t)(t >> 7) * 8192 + (t & 127);
#pragma unroll
    for (int half = 0; half < 2; ++half) {
        f32x16 acc[2];
#pragma unroll
        for (int q = 0; q < 2; ++q) {
            const int nt = half * 2 + q;
#pragma unroll
            for (int r = 0; r < 16; ++r) acc[q][r] = 0.f;
            const bf16_t* wp = W + (size_t)(nt * 32 + l31) * 128 + hi * 8; asm volatile("" : "+v"(wp));
#pragma unroll
            for (int ks = 0; ks < 8; ++ks) { const bf16x8 wf = *(const bf16x8*)(wp + ks * 16); acc[q] = __builtin_amdgcn_mfma_f32_32x32x16_bf16(wf, xf[ks], acc[q], 0, 0, 0); }
            asm volatile("" ::: "memory");
        }
        if (half == 0) {
#pragma unroll
            for (int k4 = 0; k4 < 4; ++k4) {
                float o1[4], o2[4];
#pragma unroll
                for (int j = 0; j < 4; ++j) { const int r = 4 * k4 + j, d = j + 8 * k4 + 4 * hi; const f32x2 cs = rope[d]; const float a = acc[0][r] * rstd, bb = acc[1][r] * rstd;
                    o1[j] = a * cs[0] - bb * cs[1]; o2[j] = a * cs[1] + bb * cs[0]; }
                u32x2 w1, w2; w1.x = cvt_pk_bf16(o1[0], o1[1]); w1.y = cvt_pk_bf16(o1[2], o1[3]); w2.x = cvt_pk_bf16(o2[0], o2[1]); w2.y = cvt_pk_bf16(o2[2], o2[3]);
                *(u32x2*)(ka + 8 * k4 + 4 * hi) = w1; *(u32x2*)(ka + 32 + 8 * k4 + 4 * hi) = w2;
            }
        } else {
#pragma unroll
            for (int q = 0; q < 2; ++q)
#pragma unroll
                for (int r = 0; r < 16; ++r) { const int d = q * 32 + (r & 3) + 8 * (r >> 2) + 4 * hi; vat[(size_t)d * 128] = (unsigned short)(cvt_pk_bf16(acc[q][r] * rstd, 0.f) & 0xffffu); }
        }
        asm volatile("" ::: "memory");
    }
}
__device__ __forceinline__ void cmp2_item(Frame& F, int it) {
    int lane = F.lane; asm volatile("" : "+v"(lane)); const int l31 = lane & 31, hi = lane >> 5; const int kv = it >> 7, rblk = it & 127;
    const size_t row = (size_t)rblk * 32 + l31;
    const bf16_t* hid = (const bf16_t*)(F.ws + (kv ? WS_HIDV : WS_HIDK)) + row * 256 + hi * 8;
    const bf16_t* W = (const bf16_t*)(F.ws + (kv ? WS_WC2V : WS_WC2K));
    f32x16 acc[2];
#pragma unroll
    for (int nt = 0; nt < 2; ++nt)
#pragma unroll
        for (int r = 0; r < 16; ++r) acc[nt][r] = 0.f;
#pragma unroll
    for (int ks = 0; ks < 16; ++ks) { const bf16x8 hf = *(const bf16x8*)(hid + ks * 16);
#pragma unroll
        for (int nt = 0; nt < 2; ++nt) { const bf16x8 wf = *(const bf16x8*)(W + (size_t)(nt * 32 + l31) * 256 + ks * 16 + hi * 8); acc[nt] = __builtin_amdgcn_mfma_f32_32x32x16_bf16(wf, hf, acc[nt], 0, 0, 0); } }
    if (kv == 0) {
        bf16_t* o = (bf16_t*)(F.dout + DO_KCMP) + row * 64;
#pragma unroll
        for (int nt = 0; nt < 2; ++nt)
#pragma unroll
            for (int k4 = 0; k4 < 4; ++k4) { u32x2 w; w.x = cvt_pk_bf16(acc[nt][4 * k4], acc[nt][4 * k4 + 1]); w.y = cvt_pk_bf16(acc[nt][4 * k4 + 2], acc[nt][4 * k4 + 3]); *(u32x2*)(o + nt * 32 + 8 * k4 + 4 * hi) = w; }
    } else {
        const int bg = (int)(row >> 8), c = (int)(row & 255);
        bf16_t* o = (bf16_t*)(F.dout + DO_VCMPT) + (size_t)bg * 64 * 256 + (size_t)(c >> 7) * 8192 + (c & 127);
#pragma unroll
        for (int nt = 0; nt < 2; ++nt)
#pragma unroll
            for (int r = 0; r < 16; ++r) { const int d = nt * 32 + (r & 3) + 8 * (r >> 2) + 4 * hi; o[(size_t)d * 128] = (unsigned short)(cvt_pk_bf16(acc[nt][r], 0.f) & 0xffffu); }
    }
}

constexpr int SEL_ROW = 4100;
__device__ __forceinline__ unsigned ord_key(float v) { unsigned u = __float_as_uint(v); if (u == 0x80000000u) u = 0u; return (u & 0x80000000u) ? ~u : (u | 0x80000000u); }
__device__ __forceinline__ void hist_zero(LAS unsigned* hist, int lane) {
#pragma unroll
    for (int i = 0; i < 8; ++i) *(LAS u32x4*)(hist + 36 * lane + 4 * i) = (u32x4){0u, 0u, 0u, 0u};
    LDS_WAIT(); asm volatile("" ::: "memory");
}
__device__ __forceinline__ void hist_add(LAS unsigned* hist, unsigned d) { __hip_atomic_fetch_add(hist + d + ((d >> 5) << 2), 1u, __ATOMIC_RELAXED, __HIP_MEMORY_SCOPE_WORKGROUP); }
__device__ __forceinline__ int dpp_prefix_sum(int x) {
    x += __builtin_amdgcn_update_dpp(0, x, 0x111, 0xF, 0xF, true);
    x += __builtin_amdgcn_update_dpp(0, x, 0x112, 0xF, 0xF, true);
    x += __builtin_amdgcn_update_dpp(0, x, 0x114, 0xF, 0xF, true);
    x += __builtin_amdgcn_update_dpp(0, x, 0x118, 0xF, 0xF, true);
    x += __builtin_amdgcn_update_dpp(0, x, 0x142, 0xA, 0xF, false);
    x += __builtin_amdgcn_update_dpp(0, x, 0x143, 0xC, 0xF, false);
    return x;
}
__device__ __forceinline__ unsigned hist_find(LAS unsigned* hist, int lane, unsigned& need, unsigned& binc) {
    LDS_WAIT(); asm volatile("" ::: "memory");
    unsigned lsum = 0u; const int g0 = 63 - lane;
#pragma unroll
    for (int i = 0; i < 8; ++i) { const u32x4 q4 = *(const LAS u32x4*)(hist + 36 * g0 + 4 * i); lsum += (q4.x + q4.y) + (q4.z + q4.w); }
    const unsigned suf = (unsigned)dpp_prefix_sum((int)lsum), above_lane = suf - lsum;
    const unsigned long long bal = __ballot((above_lane < need) && (suf >= need));
    const int src = bal ? (int)__builtin_ctzll(bal) : 0;
    const unsigned ab1 = (unsigned)__builtin_amdgcn_readlane((int)above_lane, src);
    const unsigned need1 = need - ab1;
    const int g0o = 63 - src, b0o = 32 * g0o;
    const unsigned cnt = (lane < 32) ? hist[36 * g0o + 31 - lane] : 0u;
    LDS_WAIT(); asm volatile("" ::: "memory");
    const unsigned pre = (unsigned)dpp_prefix_sum((int)cnt);
    const unsigned long long bal2 = __ballot((pre >= need1) && (pre - cnt < need1));
    const int l2 = bal2 ? (int)__builtin_ctzll(bal2) : 0;
    const unsigned ab2 = (unsigned)__builtin_amdgcn_readlane((int)(pre - cnt), l2);
    binc = (unsigned)__builtin_amdgcn_readlane((int)cnt, l2);
    need = need1 - ab2;
    return (unsigned)(b0o + 31 - l2);
}
__device__ __forceinline__ void dsa_select_unit(Frame& F, int b, int tq, int rep) {
    const int lane = F.lane, l31 = lane & 31, hi = lane >> 5, wave = F.wave;
    const int t0 = tq * 8;
    LAS float* S = (LAS float*)F.lds;
    {
        const int q = l31 >> 2, h = l31 & 3;
        const _Float16* QI = (const _Float16*)(F.ws + WS_QI) + ((size_t)b * SEQ + t0 + q) * 256 + h * 64 + hi * 8;
        const _Float16* KI = (const _Float16*)(F.ws + WS_KI) + (size_t)b * SEQ * 64;
        const float* WI = (const float*)(F.dout + DO_WI) + ((size_t)b * SEQ + t0 + hi) * 4;
        f32x4 w4[4];
#pragma unroll
        for (int j = 0; j < 4; ++j) w4[j] = *(const f32x4*)(WI + 8 * j);
        f16x8 qf[4];
#pragma unroll
        for (int ks = 0; ks < 4; ++ks) qf[ks] = *(const f16x8*)(QI + ks * 16);
        const int ntile = (t0 >> 5) + 1;
        LAS unsigned* Sw = (LAS unsigned*)S + hi * SEL_ROW + l31;
        for (int base = wave; base < ntile; base += 4 * NWAVES) {
            f16x8 kf[4][4];
#pragma unroll
            for (int u = 0; u < 4; ++u) { const int tile = base + NWAVES * u;
                if (tile < ntile) { const _Float16* kp = KI + (size_t)tile * 2048 + (hi * 32 + l31) * 8;
#pragma unroll
                    for (int ks = 0; ks < 4; ++ks) kf[u][ks] = *(const f16x8*)(kp + ks * 512); } }
#pragma unroll
            for (int u = 0; u < 4; ++u) { const int tile = base + NWAVES * u;
                if (tile < ntile) {
                    f32x16 s;
#pragma unroll
                    for (int r = 0; r < 16; ++r) s[r] = 0.f;
#pragma unroll
                    for (int ks = 0; ks < 4; ++ks) s = __builtin_amdgcn_mfma_f32_32x32x16_f16(qf[ks], kf[u][ks], s, 0, 0, 0);
#pragma unroll
                    for (int j = 0; j < 4; ++j) {
                        const float INF_ = __builtin_inff();
                        const float r0 = __builtin_amdgcn_fmed3f(s[4 * j], 0.f, INF_), r1 = __builtin_amdgcn_fmed3f(s[4 * j + 1], 0.f, INF_);
                        const float r2 = __builtin_amdgcn_fmed3f(s[4 * j + 2], 0.f, INF_), r3 = __builtin_amdgcn_fmed3f(s[4 * j + 3], 0.f, INF_);
                        const float v = (r0 * w4[j][0] + r1 * w4[j][1]) + (r2 * w4[j][2] + r3 * w4[j][3]);
                        Sw[2 * j * SEL_ROW + tile * 32] = (tile * 32 + l31 <= t0 + 2 * j + hi) ? ord_key(v) : 0u; }
                } }
        }
        const int ntile_pad = ((t0 + 8 + 511) >> 9) << 4;
        for (int tile = ntile + wave; tile < ntile_pad; tile += NWAVES) {
#pragma unroll
            for (int j = 0; j < 4; ++j) Sw[2 * j * SEL_ROW + tile * 32] = 0u; }
    }
    __syncthreads();
#define SEL_PASS_SPARSE(COND, DIGIT) do { int ln_ = lane; asm volatile("" : "+v"(ln_)); const unsigned Lb_ = 4095u - (unsigned)ln_; hist_zero(hist, ln_); \
        _Pragma("unroll") for (int c8_ = 0; c8_ < 8; ++c8_) { if (512 * c8_ < n) { _Pragma("unroll") for (int i8_ = 0; i8_ < 8; ++i8_) { const int i = 8 * c8_ + i8_; const unsigned o = ord[i]; const unsigned L = Lb_ - 64u * (unsigned)i; (void)L; \
            const bool m_ = (COND); if (__ballot(m_) != 0ull) { if (m_) hist_add(hist, (DIGIT)); } } } } } while (0)
#define SEL_PASS(COND, DIGIT) do { int ln_ = lane; asm volatile("" : "+v"(ln_)); const unsigned Lb_ = 4095u - (unsigned)ln_; hist_zero(hist, ln_); \
        _Pragma("unroll") for (int c8_ = 0; c8_ < 8; ++c8_) { if (512 * c8_ < n) { _Pragma("unroll") for (int i8_ = 0; i8_ < 8; ++i8_) { const int i = 8 * c8_ + i8_; const unsigned o = ord[i]; const unsigned L = Lb_ - 64u * (unsigned)i; (void)L; if (COND) hist_add(hist, (DIGIT)); } } } } while (0)
    {
        const int t = t0 + wave, n = (rep && (EXP6 & 2)) ? 1 : (t + 1);
        LAS float* row = S + wave * SEL_ROW;
        unsigned ord[64];
        { int ln_ = lane; asm volatile("" : "+v"(ln_)); const LAS unsigned* rp = (const LAS unsigned*)row + ln_;
#pragma unroll
          for (int c8 = 0; c8 < 8; ++c8) {
              if (512 * c8 < n) {
#pragma unroll
                  for (int i8 = 0; i8 < 8; ++i8) { const int i = 8 * c8 + i8; ord[i] = rp[64 * i]; }
              } else {
#pragma unroll
                  for (int i8 = 0; i8 < 8; ++i8) ord[8 * c8 + i8] = 0u;
              } } }
        LDS_WAIT(); asm volatile("" ::: "memory");
        unsigned Hs = 1u, Ls = 0u;
        if (n > 256) {
            LAS unsigned* hist = (LAS unsigned*)row;
            unsigned need = 256u;
            unsigned binc = 0u;
            SEL_PASS(true, o >> 21);
            const unsigned d0 = hist_find(hist, lane, need, binc);
            SEL_PASS((o >> 21) == d0, (o >> 10) & 2047u);
            const unsigned d1 = hist_find(hist, lane, need, binc);
            const unsigned P2 = (d0 << 11) | d1;
            Hs = P2 << 10;
            if (binc != need) {
                SEL_PASS_SPARSE((o >> 10) == P2, o & 1023u);
                const unsigned d2 = hist_find(hist, lane, need, binc);
                Hs = (P2 << 10) | d2;
                if (binc != need) {
                    SEL_PASS(o == Hs, L >> 1);
                    const unsigned t1 = hist_find(hist, lane, need, binc);
                    SEL_PASS_SPARSE(o == Hs && (L >> 1) == t1, L & 1u);
                    const unsigned t2 = hist_find(hist, lane, need, binc);
                    Ls = (t1 << 1) | t2;
                }
            }
        }
        unsigned mlo = 0u, mhi = 0u;
#define SEL_EMIT(SELEXPR) do { int ln_ = lane; asm volatile("" : "+v"(ln_)); const unsigned Lb_ = 4095u - (unsigned)ln_; \
          _Pragma("unroll") for (int c8 = 0; c8 < 8; ++c8) { if (512 * c8 < n) { \
            _Pragma("unroll") for (int i8 = 0; i8 < 8; ++i8) { const int i = 8 * c8 + i8; const unsigned L = Lb_ - 64u * (unsigned)i; (void)L; \
              const bool sel = (SELEXPR); \
              const unsigned long long bal = __ballot(sel); \
              const unsigned blo = (unsigned)bal, bhi = (unsigned)(bal >> 32); \
              asm("s_nop 1\n\tv_writelane_b32 %0, %2, %4\n\tv_writelane_b32 %1, %3, %4" : "+v"(mlo), "+v"(mhi) : "s"(blo), "s"(bhi), "n"(i)); } } } } while (0)
        if (__builtin_amdgcn_readfirstlane((int)Ls) == 0) SEL_EMIT(ord[i] >= Hs);
        else SEL_EMIT(ord[i] > Hs || (ord[i] == Hs && L >= Ls));
#undef SEL_EMIT
        u32x2* mrow = (u32x2*)(rep ? (F.dout + 96 * MiB) : (F.ws + WS_MASK)) + ((size_t)b * SEQ + t) * 64;
        mrow[lane] = (u32x2){mlo, mhi};
    }
#undef SEL_PASS
#undef SEL_PASS_SPARSE
    __syncthreads();
}

constexpr int CH_KSTR = 144, CH_VSTR = 264, CH_KB = 128 * CH_KSTR, CH_VB = 64 * CH_VSTR, CH_BYTES = CH_KB + CH_VB;
struct ChunkRegs { u32x4 k[2], v[2]; };
__device__ __forceinline__ void chunk_load(ChunkRegs& R, const bf16_t* Kbase, const bf16_t* VTbase, int ldv, int k0, int k1, int tid) {
#pragma unroll
    for (int i = 0; i < 2; ++i) { const int p = tid + 512 * i, row = p >> 3, c16 = p & 7; const int key = (row < 64) ? (k0 + row) : (k1 + row - 64);
        R.k[i] = *(const u32x4*)(Kbase + (size_t)key * 64 + c16 * 8); }
#pragma unroll
    for (int i = 0; i < 2; ++i) { const int p = tid + 512 * i, d = p >> 4, c16 = p & 15; const int ks = ((c16 < 8) ? k0 : k1) + (c16 & 7) * 8;
        R.v[i] = *(const u32x4*)(VTbase + (size_t)(ks >> 7) * 8192 + d * 128 + (ks & 127)); }
}
__device__ __forceinline__ void chunk_store(const ChunkRegs& R, LAS unsigned char* buf, int tid) {
#pragma unroll
    for (int i = 0; i < 2; ++i) { const int p = tid + 512 * i, row = p >> 3, c16 = p & 7; *(LAS u32x4*)(buf + row * CH_KSTR + c16 * 16) = R.k[i]; }
#pragma unroll
    for (int i = 0; i < 2; ++i) { const int p = tid + 512 * i, d = p >> 4, c16 = p & 15; LAS unsigned char* q = buf + CH_KB + d * CH_VSTR + c16 * 16;
        *(LAS u32x2*)q = (u32x2){R.v[i].x, R.v[i].y}; *(LAS u32x2*)(q + 8) = (u32x2){R.v[i].z, R.v[i].w}; }
}
__device__ __forceinline__ f32x16 qk_tile_lds(const bf16x8 (&qf)[4], const LAS unsigned char* buf, int tl, int l31, int hi) {
    f32x16 s;
#pragma unroll
    for (int r = 0; r < 16; ++r) s[r] = 0.f;
    const LAS unsigned char* kp = buf + (tl * 32 + l31) * CH_KSTR + hi * 16;
#pragma unroll
    for (int ks = 0; ks < 4; ++ks) { const bf16x8 kf = *(const LAS bf16x8*)(kp + ks * 32); s = __builtin_amdgcn_mfma_f32_32x32x16_bf16(kf, qf[ks], s, 0, 0, 0); }
    return s;
}
__device__ __forceinline__ void pv_tile_lds(f32x16& o0, f32x16& o1, const LAS unsigned char* buf, int tl, int l31, int hi, bf16x8 pb0, bf16x8 pb1) {
    const LAS unsigned char* vp = buf + CH_KB + l31 * CH_VSTR + (tl * 32 + 4 * hi) * 2;
#pragma unroll
    for (int dt = 0; dt < 2; ++dt)
#pragma unroll
        for (int st = 0; st < 2; ++st) {
            const s16x4 a = *(const LAS s16x4*)(vp + dt * 32 * CH_VSTR + st * 32), c2 = *(const LAS s16x4*)(vp + dt * 32 * CH_VSTR + st * 32 + 16);
            const bf16x8 vf = (bf16x8){a[0], a[1], a[2], a[3], c2[0], c2[1], c2[2], c2[3]};
            if (dt == 0) o0 = __builtin_amdgcn_mfma_f32_32x32x16_bf16(vf, st ? pb1 : pb0, o0, 0, 0, 0); else o1 = __builtin_amdgcn_mfma_f32_32x32x16_bf16(vf, st ? pb1 : pb0, o1, 0, 0, 0);
        }
}
__device__ __forceinline__ void attn_step_lds(AttnAcc& A, const bf16x8 (&qf)[4], const LAS unsigned char* buf, int tl, unsigned vmask, int l31, int hi) {
    f32x16 s = qk_tile_lds(qf, buf, tl, l31, hi);
    const int vm = (int)(vmask >> (4 * hi));
    float m0 = fmaxf(fmaxf(s[0], s[1]), s[2]), m1 = fmaxf(fmaxf(s[3], s[4]), s[5]), m2 = fmaxf(fmaxf(s[6], s[7]), s[8]), m3 = fmaxf(fmaxf(s[9], s[10]), s[11]);
    m0 = fmaxf(fmaxf(m0, s[12]), s[13]); m1 = fmaxf(fmaxf(m1, s[14]), s[15]);
    float mx = fmaxf(fmaxf(m0, m1), fmaxf(m2, m3));
    if (__ballot(mx > A.m + RESCALE_THR) != 0ull) {
        mx = max32(mx);
        const float mn = fmaxf(A.m, mx), alpha = __builtin_amdgcn_exp2f(A.m - mn); A.m = mn;
        A.l *= alpha;
#pragma unroll
        for (int r = 0; r < 16; ++r) { A.o0[r] *= alpha; A.o1[r] *= alpha; }
    }
    f32x2 acc2[2] = {(f32x2){0.f, 0.f}, (f32x2){0.f, 0.f}};
    if (__ballot(vmask != 0u && vmask != 0xffffffffu) == 0ull) {
        const float nmv = (vmask != 0u) ? -A.m : -INFINITY;
        const f32x2 nm = (f32x2){nmv, nmv};
#pragma unroll
        for (int r = 0; r < 16; r += 2) {
            const f32x2 d = (f32x2){s[r], s[r + 1]} + nm;
            const float p0 = __builtin_amdgcn_exp2f(d.x), p1 = __builtin_amdgcn_exp2f(d.y);
            s[r] = p0; s[r + 1] = p1;
            acc2[(r >> 1) & 1] += (f32x2){p0, p1};
        }
    } else {
        const f32x2 nm = (f32x2){-A.m, -A.m};
#pragma unroll
        for (int r = 0; r < 16; r += 2) {
            const f32x2 d = (f32x2){s[r], s[r + 1]} + nm;
            const int b0 = (r & 3) + 8 * (r >> 2), b1 = ((r + 1) & 3) + 8 * ((r + 1) >> 2);
            const int t0 = __builtin_amdgcn_sbfe(vm, b0, 1), t1 = __builtin_amdgcn_sbfe(vm, b1, 1);
            const float p0 = __int_as_float(__float_as_int(__builtin_amdgcn_exp2f(d.x)) & t0), p1 = __int_as_float(__float_as_int(__builtin_amdgcn_exp2f(d.y)) & t1);
            s[r] = p0; s[r + 1] = p1;
            acc2[(r >> 1) & 1] += (f32x2){p0, p1};
        }
    }
    { const f32x2 t = acc2[0] + acc2[1]; A.l += t.x + t.y; }
    u32x4 p0, p1;
    p0.x = cvt_pk_bf16(s[0], s[1]); p0.y = cvt_pk_bf16(s[2], s[3]); p0.z = cvt_pk_bf16(s[4], s[5]); p0.w = cvt_pk_bf16(s[6], s[7]);
    p1.x = cvt_pk_bf16(s[8], s[9]); p1.y = cvt_pk_bf16(s[10], s[11]); p1.z = cvt_pk_bf16(s[12], s[13]); p1.w = cvt_pk_bf16(s[14], s[15]);
    pv_tile_lds(A.o0, A.o1, buf, tl, l31, hi, __builtin_bit_cast(bf16x8, p0), __builtin_bit_cast(bf16x8, p1));
}

__device__ __forceinline__ void attn_step2_lds(AttnAcc& A0, AttnAcc& A1, const bf16x8 (&qa)[4], const bf16x8 (&qb)[4], const LAS unsigned char* buf, int tl, unsigned vmask, int l31, int hi) {
    f32x16 s0, s1;
#pragma unroll
    for (int r = 0; r < 16; ++r) { s0[r] = 0.f; s1[r] = 0.f; }
    const LAS unsigned char* kp = buf + (tl * 32 + l31) * CH_KSTR + hi * 16;
#pragma unroll
    for (int ks = 0; ks < 4; ++ks) { const bf16x8 kf = *(const LAS bf16x8*)(kp + ks * 32);
        s0 = __builtin_amdgcn_mfma_f32_32x32x16_bf16(kf, qa[ks], s0, 0, 0, 0); s1 = __builtin_amdgcn_mfma_f32_32x32x16_bf16(kf, qb[ks], s1, 0, 0, 0); }
    const int vm = (int)(vmask >> (4 * hi));
    float mxa, mxb;
    { float m0 = fmaxf(fmaxf(s0[0], s0[1]), s0[2]), m1 = fmaxf(fmaxf(s0[3], s0[4]), s0[5]), m2 = fmaxf(fmaxf(s0[6], s0[7]), s0[8]), m3 = fmaxf(fmaxf(s0[9], s0[10]), s0[11]);
      m0 = fmaxf(fmaxf(m0, s0[12]), s0[13]); m1 = fmaxf(fmaxf(m1, s0[14]), s0[15]); mxa = fmaxf(fmaxf(m0, m1), fmaxf(m2, m3)); }
    { float m0 = fmaxf(fmaxf(s1[0], s1[1]), s1[2]), m1 = fmaxf(fmaxf(s1[3], s1[4]), s1[5]), m2 = fmaxf(fmaxf(s1[6], s1[7]), s1[8]), m3 = fmaxf(fmaxf(s1[9], s1[10]), s1[11]);
      m0 = fmaxf(fmaxf(m0, s1[12]), s1[13]); m1 = fmaxf(fmaxf(m1, s1[14]), s1[15]); mxb = fmaxf(fmaxf(m0, m1), fmaxf(m2, m3)); }
    if (__ballot(mxa > A0.m + RESCALE_THR || mxb > A1.m + RESCALE_THR) != 0ull) {
        mxa = max32(mxa); mxb = max32(mxb);
        const float na = fmaxf(A0.m, mxa), nb = fmaxf(A1.m, mxb), aa = __builtin_amdgcn_exp2f(A0.m - na), ab = __builtin_amdgcn_exp2f(A1.m - nb);
        A0.m = na; A1.m = nb; A0.l *= aa; A1.l *= ab;
#pragma unroll
        for (int r = 0; r < 16; ++r) { A0.o0[r] *= aa; A0.o1[r] *= aa; A1.o0[r] *= ab; A1.o1[r] *= ab; }
    }
    const f32x2 na2 = (f32x2){-A0.m, -A0.m}, nb2 = (f32x2){-A1.m, -A1.m};
    f32x2 ca = (f32x2){0.f, 0.f}, cb = (f32x2){0.f, 0.f};
#pragma unroll
    for (int r = 0; r < 16; r += 2) {
        const f32x2 da = (f32x2){s0[r], s0[r + 1]} + na2, db = (f32x2){s1[r], s1[r + 1]} + nb2;
        const int b0 = (r & 3) + 8 * (r >> 2), b1 = ((r + 1) & 3) + 8 * ((r + 1) >> 2);
        const int t0 = __builtin_amdgcn_sbfe(vm, b0, 1), t1 = __builtin_amdgcn_sbfe(vm, b1, 1);
        const float pa0 = __int_as_float(__float_as_int(__builtin_amdgcn_exp2f(da.x)) & t0), pa1 = __int_as_float(__float_as_int(__builtin_amdgcn_exp2f(da.y)) & t1);
        const float pb0 = __int_as_float(__float_as_int(__builtin_amdgcn_exp2f(db.x)) & t0), pb1 = __int_as_float(__float_as_int(__builtin_amdgcn_exp2f(db.y)) & t1);
        s0[r] = pa0; s0[r + 1] = pa1; s1[r] = pb0; s1[r + 1] = pb1;
        ca += (f32x2){pa0, pa1}; cb += (f32x2){pb0, pb1};
    }
    A0.l += ca.x + ca.y; A1.l += cb.x + cb.y;
    u32x4 pa_0, pa_1, pb_0, pb_1;
    pa_0.x = cvt_pk_bf16(s0[0], s0[1]); pa_0.y = cvt_pk_bf16(s0[2], s0[3]); pa_0.z = cvt_pk_bf16(s0[4], s0[5]); pa_0.w = cvt_pk_bf16(s0[6], s0[7]);
    pa_1.x = cvt_pk_bf16(s0[8], s0[9]); pa_1.y = cvt_pk_bf16(s0[10], s0[11]); pa_1.z = cvt_pk_bf16(s0[12], s0[13]); pa_1.w = cvt_pk_bf16(s0[14], s0[15]);
    pb_0.x = cvt_pk_bf16(s1[0], s1[1]); pb_0.y = cvt_pk_bf16(s1[2], s1[3]); pb_0.z = cvt_pk_bf16(s1[4], s1[5]); pb_0.w = cvt_pk_bf16(s1[6], s1[7]);
    pb_1.x = cvt_pk_bf16(s1[8], s1[9]); pb_1.y = cvt_pk_bf16(s1[10], s1[11]); pb_1.z = cvt_pk_bf16(s1[12], s1[13]); pb_1.w = cvt_pk_bf16(s1[14], s1[15]);
    const bf16x8 fa0 = __builtin_bit_cast(bf16x8, pa_0), fa1 = __builtin_bit_cast(bf16x8, pa_1), fb0 = __builtin_bit_cast(bf16x8, pb_0), fb1 = __builtin_bit_cast(bf16x8, pb_1);
    const LAS unsigned char* vp = buf + CH_KB + l31 * CH_VSTR + (tl * 32 + 4 * hi) * 2;
#pragma unroll
    for (int dt = 0; dt < 2; ++dt)
#pragma unroll
        for (int st = 0; st < 2; ++st) {
            const s16x4 a = *(const LAS s16x4*)(vp + dt * 32 * CH_VSTR + st * 32), c2 = *(const LAS s16x4*)(vp + dt * 32 * CH_VSTR + st * 32 + 16);
            const bf16x8 vf = (bf16x8){a[0], a[1], a[2], a[3], c2[0], c2[1], c2[2], c2[3]};
            if (dt == 0) { A0.o0 = __builtin_amdgcn_mfma_f32_32x32x16_bf16(vf, st ? fa1 : fa0, A0.o0, 0, 0, 0); A1.o0 = __builtin_amdgcn_mfma_f32_32x32x16_bf16(vf, st ? fb1 : fb0, A1.o0, 0, 0, 0); }
            else         { A0.o1 = __builtin_amdgcn_mfma_f32_32x32x16_bf16(vf, st ? fa1 : fa0, A0.o1, 0, 0, 0); A1.o1 = __builtin_amdgcn_mfma_f32_32x32x16_bf16(vf, st ? fb1 : fb0, A1.o1, 0, 0, 0); }
        }
}
__device__ __forceinline__ void dsa_attn_unit(Frame& F, int b, int qt64, bf16_t* ybase) {
    const int lane = F.lane, l31 = lane & 31, hi = lane >> 5, sub = F.wave >> 2, hp = F.wave & 3, tid = F.tid;
    const int qt = 2 * qt64 + sub, t = qt * 32 + l31;
    const bf16_t* qrow = (const bf16_t*)(F.ws + WS_QA) + ((size_t)b * SEQ + t) * 512 + hp * 128;
    bf16x8 qa[4], qb[4];
#pragma unroll
    for (int ks = 0; ks < 4; ++ks) { qa[ks] = *(const bf16x8*)(qrow + ks * 16 + hi * 8); qb[ks] = *(const bf16x8*)(qrow + 64 + ks * 16 + hi * 8); }
    const bf16_t* K = (const bf16_t*)(F.ws + WS_KA) + (size_t)b * SEQ * 64;
    const bf16_t* VT = (const bf16_t*)(F.ws + WS_VAT) + (size_t)b * 64 * SEQ;
    AttnAcc A0, A1; attn_init(A0); attn_init(A1);
    const int nch = ((2 * qt64 + 1) >> 2) + 1;
    LAS u32x4* MW = (LAS u32x4*)(F.lds + 2 * CH_BYTES);
    const unsigned* mq = (const unsigned*)(F.ws + WS_MASK) + ((size_t)b * SEQ + qt64 * 64 + (tid & 63)) * 128;
    ChunkRegs R; u32x4 mreg = (u32x4){0u, 0u, 0u, 0u};
    chunk_load(R, K, VT, SEQ, 0, 64, tid); if (tid < 64) mreg = *(const u32x4*)(mq);
    chunk_store(R, F.lds, tid); if (tid < 64) MW[tid] = mreg;
    __syncthreads();
    for (int c = 0; c < nch; ++c) {
        const LAS unsigned char* buf = F.lds + (c & 1) * CH_BYTES;
        if (c + 1 < nch) { chunk_load(R, K, VT, SEQ, 128 * (c + 1), 128 * (c + 1) + 64, tid); if (tid < 64) mreg = *(const u32x4*)(mq + 4 * (c + 1)); }
        const u32x4 mw = MW[(c & 1) * 64 + sub * 32 + l31];
#pragma unroll
        for (int tl = 0; tl < 4; ++tl) { if (4 * c + tl <= qt) attn_step2_lds(A0, A1, qa, qb, buf, tl, mw[tl], l31, hi); }
        if (c + 1 < nch) { chunk_store(R, F.lds + ((c + 1) & 1) * CH_BYTES, tid); if (tid < 64) MW[((c + 1) & 1) * 64 + tid] = mreg; }
        __syncthreads();
    }
    bf16_t* yrow = ybase + ((size_t)b * SEQ + t) * 512 + hp * 128;
    { const float il = attn_inv_l(A0);
#pragma unroll
      for (int r = 0; r < 16; ++r) { A0.o0[r] *= il; A0.o1[r] *= il; }
      attn_store(A0.o0, A0.o1, yrow, hi); }
    { const float il = attn_inv_l(A1);
#pragma unroll
      for (int r = 0; r < 16; ++r) { A1.o0[r] *= il; A1.o1[r] *= il; }
      attn_store(A1.o0, A1.o1, yrow + 64, hi); }
}

constexpr int IMP_Q = 65;
constexpr int NSA_IMP_OFF = 2 * CH_BYTES, NSA_SEL_OFF = NSA_IMP_OFF + 2 * 4 * 32 * IMP_Q * 4, NSA_UNI_OFF = NSA_SEL_OFF + 512;
__device__ __forceinline__ void nsa_unit(Frame& F, int b, int g, int qt64, bf16_t* ybase) {
    const int lane = F.lane, l31 = lane & 31, hi = lane >> 5, sub = F.wave >> 2, rr = F.wave & 3, head = g * 4 + rr, tid = F.tid;
    const int tsub = qt64 * 64 + sub * 32, t = tsub + l31;
    LAS float* IMP = (LAS float*)(F.lds + NSA_IMP_OFF);
    LAS unsigned long long* SELM = (LAS unsigned long long*)(F.lds + NSA_SEL_OFF);
    LAS unsigned* UNI = (LAS unsigned*)(F.lds + NSA_UNI_OFF);
    const bf16_t* qrow = (const bf16_t*)(F.dout + DO_QB) + ((size_t)b * SEQ + t) * 512 + head * 64;
    bf16x8 qf[4];
#pragma unroll
    for (int ks = 0; ks < 4; ++ks) qf[ks] = *(const bf16x8*)(qrow + ks * 16 + hi * 8);
    const float* gb = (const float*)(F.dout + DO_GB) + ((size_t)b * SEQ + t) * 24;
    const float g_c = gb[head], g_s = gb[8 + head], g_w = gb[16 + head];
    const int bg = b * 2 + g;
    f32x16 out0, out1;
    ChunkRegs R;
    {
        const bf16_t* K = (const bf16_t*)(F.dout + DO_KCMP) + (size_t)bg * 256 * 64;
        const bf16_t* VT = (const bf16_t*)(F.dout + DO_VCMPT) + (size_t)bg * 64 * 256;
        if (tid == 0) { UNI[0] = 0u; UNI[1] = 0u; }
        chunk_load(R, K, VT, 256, 0, 64, tid); chunk_store(R, F.lds, tid);
        chunk_load(R, K, VT, 256, 128, 192, tid); chunk_store(R, F.lds + CH_BYTES, tid);
        __syncthreads();
        const int cl = (t - 31) >> 4;
        const int clw = tsub >> 4;
        const int ntile = (clw >> 5) + 1;
        float m = -1e30f, l = 0.f;
        for (int tile = 0; tile < ntile; ++tile) {
            f32x16 s = qk_tile_lds(qf, F.lds + (tile >> 2) * CH_BYTES, tile & 3, l31, hi);
            float mx = -INFINITY;
#pragma unroll
            for (int r = 0; r < 16; ++r) { const int c = tile * 32 + (r & 3) + 8 * (r >> 2) + 4 * hi; if (c > cl) s[r] = -INFINITY; mx = fmaxf(mx, s[r]); }
            const float mn = fmaxf(m, mx); float ls = 0.f;
#pragma unroll
            for (int r = 0; r < 16; ++r) ls += __builtin_amdgcn_exp2f(s[r] - mn);
            l = l * __builtin_amdgcn_exp2f(m - mn) + ls; m = mn;
        }
        { const float mo = swap32(m, hi), lo = swap32(l, hi); const float mn = fmaxf(m, mo);
          l = l * __builtin_amdgcn_exp2f(m - mn) + lo * __builtin_amdgcn_exp2f(mo - mn); m = mn; }
        const float il = l > 0.f ? __builtin_amdgcn_rcpf(l) : 0.f;
        f32x16 o0, o1;
#pragma unroll
        for (int r = 0; r < 16; ++r) { o0[r] = 0.f; o1[r] = 0.f; }
        float carry = 0.f;
        LAS float* imp = IMP + ((sub * 4 + rr) * 32 + l31) * IMP_Q;
#pragma unroll 1
        for (int tile = 0; tile < 8; ++tile) {
            f32x16 s;
#pragma unroll
            for (int r = 0; r < 16; ++r) s[r] = 0.f;
            if (tile < ntile) {
                const LAS unsigned char* buf = F.lds + (tile >> 2) * CH_BYTES;
                s = qk_tile_lds(qf, buf, tile & 3, l31, hi);
#pragma unroll
                for (int r = 0; r < 16; ++r) { const int c = tile * 32 + (r & 3) + 8 * (r >> 2) + 4 * hi; s[r] = (c > cl) ? 0.f : __builtin_amdgcn_exp2f(s[r] - m) * il; }
                u32x4 p0, p1;
                p0.x = cvt_pk_bf16(s[0], s[1]); p0.y = cvt_pk_bf16(s[2], s[3]); p0.z = cvt_pk_bf16(s[4], s[5]); p0.w = cvt_pk_bf16(s[6], s[7]);
                p1.x = cvt_pk_bf16(s[8], s[9]); p1.y = cvt_pk_bf16(s[10], s[11]); p1.z = cvt_pk_bf16(s[12], s[13]); p1.w = cvt_pk_bf16(s[14], s[15]);
                pv_tile_lds(o0, o1, buf, tile & 3, l31, hi, __builtin_bit_cast(bf16x8, p0), __builtin_bit_cast(bf16x8, p1));
            }
            float rec[4], sum4[4];
#pragma unroll
            for (int k = 0; k < 4; ++k) { sum4[k] = (s[4 * k] + s[4 * k + 1]) + (s[4 * k + 2] + s[4 * k + 3]); rec[k] = swap32(s[4 * k + 3], hi); }
#pragma unroll
            for (int k = 0; k < 4; ++k) { const float add = hi ? rec[k] : (k == 0 ? carry : rec[k - 1]); imp[8 * tile + 2 * k + hi] = sum4[k] + add; }
            carry = rec[3];
        }
#pragma unroll
        for (int r = 0; r < 16; ++r) { out0[r] = g_c * o0[r]; out1[r] = g_c * o1[r]; }
    }
    __syncthreads();
    {
        const int q64 = F.wave * 8 + (lane >> 3), kk = lane & 7, qs = q64 >> 5, ql = q64 & 31, blkq = qt64;
        unsigned long long msk = 0ull;
        if (blkq < 16) { msk = (1ull << (blkq + 1)) - 1ull; }
        else {
            const LAS float* v0 = IMP + ((qs * 4 + 0) * 32 + ql) * IMP_Q; const LAS float* v1 = v0 + 32 * IMP_Q; const LAS float* v2 = v1 + 32 * IMP_Q; const LAS float* v3 = v2 + 32 * IMP_Q;
            float v[8];
#pragma unroll
            for (int i = 0; i < 8; ++i) { const int j = 8 * i + kk; float x = ((v0[j] + v1[j]) + v2[j]) + v3[j]; if (j == 0 || j == blkq || j == blkq - 1) x += 1e4f; v[i] = (j <= blkq) ? x : -INFINITY; }
#pragma unroll 1
            for (int it = 0; it < 16; ++it) {
                float bv = v[0]; int bj = kk;
#pragma unroll
                for (int i = 1; i < 8; ++i) { if (v[i] > bv) { bv = v[i]; bj = 8 * i + kk; } }
#define SELRED(ctrl) do { const float ov = DPP_F(bv, ctrl); const int oj = __builtin_amdgcn_update_dpp(0, bj, ctrl, 0xF, 0xF, true); if (ov > bv || (ov == bv && oj < bj)) { bv = ov; bj = oj; } } while (0)
                SELRED(0xB1); SELRED(0x4E); SELRED(0x141);
#undef SELRED
                msk |= 1ull << bj;
                const bool mine = (bj & 7) == kk; const int bi = bj >> 3;
#pragma unroll
                for (int i = 0; i < 8; ++i) { if (mine && i == bi) v[i] = -INFINITY; }
            }
        }
        if (kk == 0) { SELM[q64] = msk; __hip_atomic_fetch_or(UNI, (unsigned)msk, __ATOMIC_RELAXED, __HIP_MEMORY_SCOPE_WORKGROUP); __hip_atomic_fetch_or(UNI + 1, (unsigned)(msk >> 32), __ATOMIC_RELAXED, __HIP_MEMORY_SCOPE_WORKGROUP); }
    }
    __syncthreads();
    {
        const unsigned long long selm = SELM[sub * 32 + l31];
        unsigned long long uni = ((unsigned long long)(unsigned)__builtin_amdgcn_readfirstlane((int)UNI[1]) << 32) | (unsigned long long)(unsigned)__builtin_amdgcn_readfirstlane((int)UNI[0]);
        const bf16_t* K = (const bf16_t*)(F.ws + WS_KS) + (size_t)bg * SEQ * 64;
        const bf16_t* VT = (const bf16_t*)(F.ws + WS_VST) + (size_t)bg * 64 * SEQ;
        AttnAcc A; attn_init(A);
        int j0 = (int)__builtin_ctzll(uni); uni &= uni - 1ull;
        int j1 = uni ? (int)__builtin_ctzll(uni) : -1; if (uni) uni &= uni - 1ull;
        chunk_load(R, K, VT, SEQ, 64 * j0, 64 * (j1 < 0 ? j0 : j1), tid); chunk_store(R, F.lds, tid);
        __syncthreads();
        for (int c = 0;; ++c) {
            const LAS unsigned char* buf = F.lds + (c & 1) * CH_BYTES;
            int n0 = -1, n1 = -1;
            if (uni) { n0 = (int)__builtin_ctzll(uni); uni &= uni - 1ull; if (uni) { n1 = (int)__builtin_ctzll(uni); uni &= uni - 1ull; } }
            if (n0 >= 0) chunk_load(R, K, VT, SEQ, 64 * n0, 64 * (n1 < 0 ? n0 : n1), tid);
#pragma unroll
            for (int tl = 0; tl < 4; ++tl) {
                const int j = (tl < 2) ? j0 : j1;
                if (j >= 0) {
                    const int key0 = 64 * j + 32 * (tl & 1);
                    const bool mine = (selm >> j) & 1ull;
                    unsigned vm = 0u;
                    if (mine) { const int d = t - key0; vm = d >= 31 ? 0xffffffffu : (d < 0 ? 0u : ((2u << d) - 1u)); }
                    if (__ballot(vm != 0u) != 0ull) attn_step_lds(A, qf, buf, tl, vm, l31, hi);
                }
            }
            if (n0 >= 0) chunk_store(R, F.lds + ((c + 1) & 1) * CH_BYTES, tid);
            __syncthreads();
            if (n0 < 0) break;
            j0 = n0; j1 = n1;
        }
        const float il = attn_inv_l(A) * g_s;
#pragma unroll
        for (int r = 0; r < 16; ++r) { out0[r] += il * A.o0[r]; out1[r] += il * A.o1[r]; }
    }
    {
        const bf16_t* K = (const bf16_t*)(F.ws + WS_KW) + (size_t)bg * SEQ * 64;
        const bf16_t* VT = (const bf16_t*)(F.ws + WS_VWT) + (size_t)bg * 64 * SEQ;
        AttnAcc A; attn_init(A);
        const int T = 2 * qt64; int tile_lo = T - 16; if (tile_lo < 0) tile_lo = 0;
        const int kstart = tile_lo * 32, ntl = T + 2 - tile_lo, nch = (ntl + 3) >> 2;
        chunk_load(R, K, VT, SEQ, kstart, kstart + 64, tid); chunk_store(R, F.lds, tid);
        __syncthreads();
        for (int c = 0; c < nch; ++c) {
            const LAS unsigned char* buf = F.lds + (c & 1) * CH_BYTES;
            if (c + 1 < nch) chunk_load(R, K, VT, SEQ, kstart + 128 * (c + 1), kstart + 128 * (c + 1) + 64, tid);
#pragma unroll
            for (int tl = 0; tl < 4; ++tl) {
                const int key0 = kstart + 128 * c + 32 * tl;
                const int dhi = t - key0, dlo = t - 511 - key0;
                unsigned vm = dhi >= 31 ? 0xffffffffu : (dhi < 0 ? 0u : ((2u << dhi) - 1u));
                if (dlo > 0) vm &= (dlo >= 32 ? 0u : ~((1u << dlo) - 1u));
                if (__ballot(vm != 0u) != 0ull) attn_step_lds(A, qf, buf, tl, vm, l31, hi);
            }
            if (c + 1 < nch) chunk_store(R, F.lds + ((c + 1) & 1) * CH_BYTES, tid);
            __syncthreads();
        }
        const float il = attn_inv_l(A) * g_w;
#pragma unroll
        for (int r = 0; r < 16; ++r) { out0[r] += il * A.o0[r]; out1[r] += il * A.o1[r]; }
    }
    attn_store(out0, out1, ybase + ((size_t)b * SEQ + t) * 512 + head * 64, hi);
    __syncthreads();
}

#ifndef DBG_PROBE
#define DBG_PROBE 0
#endif
#ifndef DBG_TS
#define DBG_TS -1
#endif
#ifndef DBG_DUP
#define DBG_DUP -1
#endif
#define REPS(k) for (int rep = 0; rep < ((DBG_DUP == (k)) ? 2 : 1); ++rep)
#define REPBAR() do { if (rep == 0 && DBG_DUP >= 0) xcd_barrier(bar); } while (0)

__device__ __forceinline__ void naive_ffn1_row(Frame& F, const float* out) {
    LAS float* u = (LAS float*)F.lds; LAS float* h = u + 1024;
    LAS float* red = h + 2816;
    const int row = F.blk * 128 + 77;
    const float* x = (DBG_PROBE == 9 ? (const float*)(F.ws + WS_XR) : INP(0)) + (size_t)row * DM; const float* mod = (const float*)(F.ws + WS_MOD) + (size_t)(row >> 12) * NMOD + (DBG_PROBE == 9 ? 6 * DM : 0);
    for (int k = F.tid; k < DM; k += NTHREADS) u[k] = x[k] * (1.0f + mod[DM + k]) + mod[k];
    __syncthreads();
    const float* win = INP(DBG_PROBE == 9 ? 22 : 4); const float* wout = INP(DBG_PROBE == 9 ? 23 : 5);
    for (int j = F.tid; j < DFF; j += NTHREADS) { float a = 0.f, b = 0.f;
        for (int k = 0; k < DM; ++k) { a += u[k] * win[(size_t)k * NFF + j]; b += u[k] * win[(size_t)k * NFF + DFF + j]; }
        h[j] = (a / (1.0f + __expf(-a))) * b; }
    __syncthreads();
    float sd = 0.f, sr = 0.f;
    for (int n = F.tid; n < DM; n += NTHREADS) { float f = 0.f;
        for (int k = 0; k < DFF; ++k) f += h[k] * wout[(size_t)k * DM + n];
        const float term = 0.5f * mod[2 * DM + n] * f; const float fast = out[(size_t)row * DM + n] - ALPHA * x[n];
        sd += fabsf(fast - term); sr += fabsf(term); }
    sd = wave_sum(sd); sr = wave_sum(sr);
    if (F.lane == 0) { red[F.wave] = sd; red[8 + F.wave] = sr; }
    __syncthreads();
    if (F.tid == 0) { float a = 0.f, b = 0.f; for (int w = 0; w < 8; ++w) { a += red[w]; b += red[8 + w]; }
        float* slot = (float*)(F.ws + WS_CTL + 32768); slot[2 * F.blk] = a; slot[2 * F.blk + 1] = b; }
}
__device__ __forceinline__ void probe_stage(Frame& F, float* out, const XcdBarrier& bar) {
    if (DBG_PROBE == 8 || DBG_PROBE == 9) { naive_ffn1_row(F, out); xcd_barrier(bar); }
    if (DBG_PROBE == 11) {
        LAS float* red = (LAS float*)F.lds; float sd = 0.f, sr = 0.f;
        const int row = F.blk * 128 + 77; const float* y = out + (size_t)row * DM; const float* mod = (const float*)(F.ws + WS_MOD) + (size_t)(row >> 12) * NMOD;
        float mean = 0.f; for (int k = 0; k < DM; ++k) mean += y[k]; mean /= DM;
        float var = 0.f; for (int k = 0; k < DM; ++k) { const float d = y[k] - mean; var += d * d; } var /= DM;
        const float rstd = 1.0f / sqrtf(var + LN_EPS);
        for (int n = F.tid; n < DM; n += NTHREADS) { const float xn = (y[n] - mean) * rstd * INP(6)[n] + INP(7)[n];
            const float un = xn * (1.0f + mod[4 * DM + n]) + mod[3 * DM + n];
            sd += fabsf(xn - ((const float*)(F.ws + WS_XR))[(size_t)row * DM + n]) + fabsf(un - bf2f(((const bf16_t*)(F.ws + WS_U))[(size_t)row * DM + n])); sr += fabsf(xn) + fabsf(un); }
        sd = wave_sum(sd); sr = wave_sum(sr);
        if (F.lane == 0) { red[F.wave] = sd; red[8 + F.wave] = sr; }
        __syncthreads();
        if (F.tid == 0) { float a = 0.f, b2 = 0.f; for (int w = 0; w < 8; ++w) { a += red[w]; b2 += red[8 + w]; }
            float* slot = (float*)(F.ws + WS_CTL + 32768); slot[2 * F.blk] = a; slot[2 * F.blk + 1] = b2; }
        xcd_barrier(bar);
    }
    if (DBG_PROBE == 10) {
        LAS float* red = (LAS float*)F.lds; float sd = 0.f, sr = 0.f;
        if (F.tid < 288) { const int b = F.tid / 36, n = 36 * F.blk + F.tid % 36; float acc = INP(3)[n];
            for (int k = 0; k < DM; ++k) { const float c = INP(1)[b * DM + k]; acc += (c / (1.0f + __expf(-c))) * INP(2)[(size_t)k * NMOD + n]; }
            const float m = ((const float*)(F.ws + WS_MOD))[(size_t)b * NMOD + n]; sd = fabsf(m - acc); sr = fabsf(acc); }
        sd = wave_sum(sd); sr = wave_sum(sr);
        if (F.lane == 0) { red[F.wave] = sd; red[8 + F.wave] = sr; }
        __syncthreads();
        if (F.tid == 0) { float a = 0.f, b2 = 0.f; for (int w = 0; w < 8; ++w) { a += red[w]; b2 += red[8 + w]; }
            float* slot = (float*)(F.ws + WS_CTL + 32768); slot[2 * F.blk] = a; slot[2 * F.blk + 1] = b2; }
        xcd_barrier(bar);
    }
    float val = 0.f;
    if (F.blk == 0) {
        float acc = 0.f; const int N = 1 << 18;
        for (int i = F.tid; i < N; i += NTHREADS) {
            float v = 0.f;
            if (DBG_PROBE == 1) v = ((const float*)(F.ws + WS_MOD))[i % (8 * NMOD)];
            if (DBG_PROBE == 2) v = bf2f(((const bf16_t*)(F.ws + WS_W1IN))[i]);
            if (DBG_PROBE == 3) v = bf2f(((const bf16_t*)(F.ws + WS_HF))[i]);
            if (DBG_PROBE == 4) v = bf2f(((const bf16_t*)(F.ws + WS_U))[i]);
            if (DBG_PROBE == 5) v = ((const float*)(F.ws + WS_XR))[i];
            if (DBG_PROBE == 6) v = bf2f(((const bf16_t*)(F.ws + WS_W1OUT))[i]);
            if (DBG_PROBE == 7) v = out[i] - ALPHA * INP(0)[i];
            acc += fabsf(v);
        }
        acc = wave_sum(acc);
        LAS float* red = (LAS float*)F.lds;
        if (F.lane == 0) red[F.wave] = acc;
        __syncthreads();
        float s = 0.f; for (int w = 0; w < NWAVES; ++w) s += red[w];
        val = 1000.0f * s / (float)N;
        if (DBG_TS >= 0) { const unsigned long long* ts = (const unsigned long long*)(F.ws + WS_CTL + 40960); val = 0.01f * (float)(ts[DBG_TS + 1] - ts[DBG_TS]); }
        if (DBG_PROBE >= 8) { const float* slot = (const float*)(F.ws + WS_CTL + 32768); float a = 0.f, b = 0.f; for (int i = 0; i < 256; ++i) { a += slot[2 * i]; b += slot[2 * i + 1]; } val = 100000.0f * a / b; }
    }
    xcd_barrier(bar);
    for (size_t i = (size_t)F.blk * NTHREADS + F.tid; i < (size_t)MROWS * DM / 4; i += (size_t)F.G * NTHREADS) ((f32x4*)out)[i] = (f32x4){i == 0 ? val : 0.f, 0.f, 0.f, 0.f};
}

__global__ void __launch_bounds__(NTHREADS, 2) mk_fwd(Args args) {
    extern __shared__ __attribute__((aligned(16))) unsigned char lds_raw[];
    cg::grid_group grid = cg::this_grid();
    Frame F;
    F.lds = (LAS unsigned char*)lds_raw; F.in = args.in;
    LAS int* qword = (LAS int*)(F.lds + LDS_BYTES - 16);
    volatile LAS unsigned* bst = (volatile LAS unsigned*)(F.lds + LDS_BYTES - 32);
    if (threadIdx.x < 8) ((LAS unsigned*)(F.lds + LDS_BYTES - 32))[threadIdx.x] = 0u;
    __syncthreads();
    XcdBarrier bar = xcd_barrier_post((unsigned*)(args.ws + WS_CTL) + CW_BAR, bst);

    const int lo = args.ph_lo, hi = args.ph_hi;
    unsigned char* ws_ = args.ws; float* out_ = args.out; int tid_ = threadIdx.x;
#define RELAUNDER() do { ws_ = launder_ptr(ws_); out_ = launder_ptr(out_); asm volatile("" : "+v"(tid_)); \
        { int b_ = blockIdx.x, g_ = gridDim.x; asm volatile("" : "+v"(b_), "+v"(g_)); F.blk = __builtin_amdgcn_readfirstlane(b_); F.G = __builtin_amdgcn_readfirstlane(g_); } \
        F.ws = ws_; F.dout = (unsigned char*)out_; F.tid = tid_; F.lane = tid_ & 63; F.wave = __builtin_amdgcn_readfirstlane(tid_ >> 6); } while (0)
#define IN(k) (lo <= (k) && (k) < hi && STG(k))
#define SYNC(k) do { if (lo <= (k) && (k) + 1 < hi) { if ((k) == 9 && DBG_DUP < 0) { asm volatile("s_waitcnt vmcnt(0)" ::: "memory"); __syncthreads(); } else xcd_barrier(bar); } if (DBG_TS >= 0 && blockIdx.x == 0 && threadIdx.x == 0) ((unsigned long long*)(args.ws + WS_CTL + 40960))[(k) + 1] = __builtin_amdgcn_s_memrealtime(); } while (0)
#define MODP ((const float*)(F.ws + WS_MOD))
#define UBUF ((bf16_t*)(F.ws + WS_U))
#define STATBUF ((f32x2*)(F.ws + WS_XR))
#define YBUF ((bf16_t*)(F.ws + WS_XR + 64 * MiB))
#define HFBUF ((bf16_t*)(F.ws + WS_HF))
#define GW (F.blk * NWAVES + F.wave)
#define NGW (F.G * NWAVES)
    if (DBG_TS >= 0 && blockIdx.x == 0 && threadIdx.x == 0) ((unsigned long long*)(args.ws + WS_CTL + 40960))[0] = __builtin_amdgcn_s_memrealtime();
    if (IN(0)) REPS(0) { RELAUNDER(); stage_prologue(F, args);  REPBAR(); }
    SYNC(0);
    if (IN(1)) REPS(1) { RELAUNDER(); stage_mod_u1(F);  REPBAR(); }
    SYNC(1);
    if (IN(2)) REPS(2) { RELAUNDER();
        pg8::Gemm g{UBUF, (const bf16_t*)(F.ws + WS_W1IN), MROWS, NFF, DM, DM}; pg8::StaticOrder S; S.init(MROWS, NFF, F.G, F.blk);
        EpiSwiglu E{HFBUF}; pg8::gemm_phase(F.lds, g, S, E); REPBAR(); }
    SYNC(2);
    if (IN(3)) REPS(3) { RELAUNDER();
        pg8::Gemm g{HFBUF, (const bf16_t*)(F.ws + WS_W1OUT), MROWS, DM, DFF, DFF}; pg8::StaticOrder S; S.init(MROWS, DM, F.G, F.blk);
        EpiResid<true> E{INP(0), MODP + 2 * DM, YBUF, nullptr, nullptr, nullptr, FFN1_COEF, 0}; pg8::gemm_phase(F.lds, g, S, E); REPBAR(); }
    SYNC(3);
    if (IN(4)) REPS(4) { RELAUNDER(); stage_rows<1>(F, YBUF, nullptr, STATBUF, UBUF, INP(6), INP(7), MODP + 3 * DM, MODP + 4 * DM);  REPBAR(); }
    SYNC(4);
#if !DBG_SKIP_MIXER
    if (IN(5)) REPS(5) { RELAUNDER();
        pg8::Gemm g{UBUF, (const bf16_t*)(F.ws + WS_WMIX), MROWS, NMIX, DM, DM}; pg8::StaticOrder S; S.init(MROWS, NMIX, F.G, F.blk);
        EpiMix E{F.ws, F.dout}; pg8::gemm_phase(F.lds, g, S, E);
        if (rep == 0 && F.blk >= 128) { RELAUNDER(); ffn2_transposes(F, args, (F.blk - 128) * NWAVES + F.wave, 128 * NWAVES); }
        REPBAR(); }
    SYNC(5);
    if (IN(6)) REPS(6) {
        RELAUNDER();
        { const int kv = F.blk >> 4;
          pg8::Gemm g{(const bf16_t*)(F.ws + (kv ? WS_VC : WS_KC)), (const bf16_t*)(F.ws + (kv ? WS_WC1V : WS_WC1K)), 4096, 256, 2048, 1024};
          pg8::StaticOrder S; S.init(4096, 256, F.G, F.blk < 32 ? (F.blk & 15) : -1);
          EpiCmp1 E{F.ws, kv}; pg8::gemm_phase(F.lds, g, S, E); }
        RELAUNDER();
        for (int it = GW; it < MROWS / 32; it += NGW) kvup_item(F, it);
        __syncthreads();
        RELAUNDER();
        if (rep == 0 || (EXP6 & 1)) {
            int unext = 0;
            if (F.tid == 0) unext = (int)atomicAdd((unsigned*)(F.ws + WS_CTL) + CW_QSEL + 16 * rep, 1u);
            for (;;) { if (F.tid == 0) *qword = unext; __syncthreads(); const int u = *qword; __syncthreads(); if (u >= NB * 512) break;
                if (F.tid == 0) unext = (int)atomicAdd((unsigned*)(F.ws + WS_CTL) + CW_QSEL + 16 * rep, 1u);
                dsa_select_unit(F, u & 7, 511 - (u >> 3), rep); }
        }
        REPBAR();
    }
    SYNC(6);
    if (IN(7)) REPS(7) {
        RELAUNDER();
        unsigned* c2done = (unsigned*)(F.ws + WS_CTL) + CW_C2 + 16 * rep;
        for (int it = GW; it < 256; it += NGW) { cmp2_item(F, it);
            __builtin_amdgcn_fence(__ATOMIC_RELEASE, "agent");
            if (F.lane == 0) __hip_atomic_fetch_add(c2done, 1u, __ATOMIC_RELAXED, __HIP_MEMORY_SCOPE_AGENT); }
        RELAUNDER();
        int tka = 0, tkb = 0;
        if (F.tid == 0) { tka = (int)atomicAdd((unsigned*)(F.ws + WS_CTL) + CW_QDSA + 16 * rep, 1u); tkb = (int)atomicAdd((unsigned*)(F.ws + WS_CTL) + CW_QNSA + 16 * rep, 1u); }
        for (;;) { if (F.tid == 0) *qword = tka; __syncthreads(); const int u = *qword; __syncthreads(); if (u >= NB * 64) break;
            if (F.tid == 0) tka = (int)atomicAdd((unsigned*)(F.ws + WS_CTL) + CW_QDSA + 16 * rep, 1u);
            dsa_attn_unit(F, u & 7, 63 - (u >> 3), rep ? (bf16_t*)(F.dout + 96 * MiB) : (bf16_t*)(F.ws + WS_QA)); }
        RELAUNDER();
        if (F.tid == 0) { while (__hip_atomic_load(c2done, __ATOMIC_RELAXED, __HIP_MEMORY_SCOPE_AGENT) < 256u) __builtin_amdgcn_s_sleep(4);
            __builtin_amdgcn_fence(__ATOMIC_ACQUIRE, "agent"); }
        __syncthreads();
        for (;;) { if (F.tid == 0) *qword = tkb; __syncthreads(); const int u = *qword; __syncthreads(); if (u >= NB * 2 * 64) break;
            if (F.tid == 0) tkb = (int)atomicAdd((unsigned*)(F.ws + WS_CTL) + CW_QNSA + 16 * rep, 1u);
            nsa_unit(F, (u & 15) >> 1, u & 1, 63 - (u >> 4), rep ? (bf16_t*)(F.dout + 96 * MiB) : (bf16_t*)(F.dout + DO_QB)); }
        REPBAR();
    }
    SYNC(7);
    if (IN(9)) REPS(9) { RELAUNDER();
        pg8::Gemm g{(const bf16_t*)(F.ws + WS_QA), (const bf16_t*)(F.ws + WS_WBRA), MROWS, DM, 512, 512}; pg8::StaticOrder S; S.init(MROWS, DM, F.G, F.blk);
        EpiGate E{(const bf16_t*)(F.ws + WS_GATE), 0, nullptr, (bf16_t*)(F.dout + DO_T)}; pg8::gemm_phase(F.lds, g, S, E); REPBAR(); }
    SYNC(9);
    if (IN(10)) REPS(10) { RELAUNDER();
        pg8::Gemm g{(const bf16_t*)(F.dout + DO_QB), (const bf16_t*)(F.ws + WS_WBRB), MROWS, DM, 512, 512}; pg8::StaticOrder S; S.init(MROWS, DM, F.G, F.blk);
        EpiGate E{(const bf16_t*)(F.ws + WS_GATE), 1024, (const bf16_t*)(F.dout + DO_T), UBUF}; pg8::gemm_phase(F.lds, g, S, E); REPBAR(); }
    SYNC(10);
    if (IN(11)) REPS(11) { RELAUNDER();
        pg8::Gemm g{UBUF, (const bf16_t*)(F.ws + WS_WMO), MROWS, DM, DM, DM}; pg8::StaticOrder S; S.init(MROWS, DM, F.G, F.blk);
        EpiResid<false> E{nullptr, MODP + 5 * DM, YBUF, STATBUF, INP(6), INP(7), 1.0f, 0}; pg8::gemm_phase(F.lds, g, S, E); REPBAR(); }
    SYNC(11);
#else
    SYNC(5); SYNC(6); SYNC(7); SYNC(8); SYNC(9); SYNC(10);
    if (IN(11)) REPS(11) { RELAUNDER();
        for (size_t i = (size_t)F.blk * NTHREADS + F.tid; i < (size_t)MROWS * DM / 4; i += (size_t)F.G * NTHREADS) ((f32x4*)out_)[i] = ((const f32x4*)XRBUF)[i] * ALPHA; REPBAR(); }
    SYNC(11);
#endif
    if (IN(12)) REPS(12) { RELAUNDER(); stage_rows<1>(F, YBUF, nullptr, STATBUF, UBUF, INP(20), INP(21), MODP + 6 * DM, MODP + 7 * DM);  REPBAR(); }
    SYNC(12);
    if (IN(13)) REPS(13) { RELAUNDER();
        pg8::Gemm g{UBUF, (const bf16_t*)(F.ws + WS_W2IN), MROWS, NFF, DM, DM}; pg8::StaticOrder S; S.init(MROWS, NFF, F.G, F.blk);
        EpiSwiglu E{HFBUF}; pg8::gemm_phase(F.lds, g, S, E); REPBAR(); }
    SYNC(13);
    if (IN(14)) REPS(14) { RELAUNDER();
        pg8::Gemm g{HFBUF, (const bf16_t*)(F.ws + WS_W2OUT), MROWS, DM, DFF, DFF}; pg8::StaticOrder S; S.init(MROWS, DM, F.G, F.blk);
        EpiResid<false> E{nullptr, MODP + 8 * DM, YBUF, STATBUF, INP(20), INP(21), FFN2_COEF, 0}; pg8::gemm_phase(F.lds, g, S, E); REPBAR(); }
    SYNC(14);
    if (IN(15)) REPS(15) { RELAUNDER(); stage_rows<2>(F, YBUF, out_, nullptr, nullptr, INP(24), INP(25), nullptr, nullptr);  REPBAR(); }
    SYNC(15);
    if (DBG_PROBE || DBG_TS >= 0) { xcd_barrier(bar); RELAUNDER(); probe_stage(F, out_, bar); }
}

extern "C" void kernel_launch(void* const* d_in, const int* in_sizes, int n_in, void* d_out, int out_size, void* d_ws, size_t ws_size, hipStream_t stream) {
    static int grid = 0;
    if (grid == 0) {
        if (n_in != 26 || out_size != MROWS * DM || ws_size < WS_END) { fprintf(stderr, "kernel_launch: unexpected shapes (n_in %d out %d ws %zu)\n", n_in, out_size, ws_size); grid = -1; return; }
        if (hipFuncSetAttribute((const void*)mk_fwd, hipFuncAttributeMaxDynamicSharedMemorySize, LDS_BYTES) != hipSuccess) { fprintf(stderr, "kernel_launch: hipFuncSetAttribute failed\n"); grid = -1; return; }
        int dev = 0, cus = 0, per_cu = 0;
        hipGetDevice(&dev); hipDeviceGetAttribute(&cus, hipDeviceAttributeMultiprocessorCount, dev);
        hipOccupancyMaxActiveBlocksPerMultiprocessor(&per_cu, (const void*)mk_fwd, NTHREADS, LDS_BYTES);
        (void)hipGetLastError();
        if (per_cu < 1 || cus != 256) fprintf(stderr, "kernel_launch: note: occupancy %d blocks/CU, %d CUs\n", per_cu, cus);
        grid = 256;
    }
    if (grid < 0) return;
    hipMemsetAsync((char*)d_ws + WS_CTL, 0, CTL_ZERO_BYTES, stream);
    Args a{};
    for (int i = 0; i < 26; ++i) a.in[i] = (const float*)d_in[i];
    a.out = (float*)d_out; a.ws = (unsigned char*)d_ws;
    for (int d = 0; d < 32; ++d) a.inv_freq[d] = powf(10000.0f, -(float)d / 32.0f);
    a.ph_lo = STAGE_LO; a.ph_hi = STAGE_HI;
    void* kargs[] = {&a};
    hipError_t e = hipLaunchCooperativeKernel((const void*)mk_fwd, dim3(grid), dim3(NTHREADS), kargs, LDS_BYTES, stream);
    if (e != hipSuccess) fprintf(stderr, "kernel_launch: cooperative launch failed: %s\n", hipGetErrorString(e));
}
```
